# Optimizing an MI355X kernel written in HIP

```python
import numpy as np
import jax
import jax.numpy as jnp
from jax import lax

D_MODEL = 1024
BATCH = 32
SEQ = 2048
DEPTH = 2

NSA_HEADS = 8
NSA_KV_HEADS = 2
NSA_HEAD_DIM = 64
NSA_GROUP = NSA_HEADS // NSA_KV_HEADS
NSA_WIDTH = NSA_HEADS * NSA_HEAD_DIM
NSA_KV_WIDTH = NSA_KV_HEADS * NSA_HEAD_DIM
CMP_BLOCK = 32
CMP_STRIDE = 16
CMP_HIDDEN = 256
SEL_BLOCK = 64
N_SELECT = 8
WINDOW = 512
QUERY_BLOCK = 64

GDN_HEADS = 4
GDN_HEAD_DIM = 128
GDN_WIDTH = GDN_HEADS * GDN_HEAD_DIM
GDN_CONV = 4
GDN_CHUNK = 64

MIX_WIDTH = NSA_WIDTH + GDN_WIDTH
D_FF = 2816
FFN_CONV = 3
EPS = 1e-6

SPLIT_SIZES = (NSA_WIDTH, 6 * NSA_KV_WIDTH, 3 * NSA_HEADS, 3 * GDN_WIDTH, GDN_WIDTH, GDN_HEADS, GDN_HEADS)
IN_WIDTH = sum(SPLIT_SIZES)
SPLIT_POINTS = tuple(int(v) for v in np.cumsum(SPLIT_SIZES)[:-1])

kernel_name = "hymba_nsa_gdn_convffn"


def rmsnorm(x, g):
    xf = x.astype(jnp.float32)
    y = xf * lax.rsqrt(jnp.mean(xf * xf, axis=-1, keepdims=True) + EPS)
    return (y * g.astype(jnp.float32)).astype(x.dtype)


def l2norm(x):
    xf = x.astype(jnp.float32)
    return xf * lax.rsqrt(jnp.sum(xf * xf, axis=-1, keepdims=True) + EPS)


def causal_dwconv(x, w):
    width = w.shape[0]
    s = x.shape[1]
    xp = jnp.pad(x, ((0, 0), (width - 1, 0), (0, 0)))
    y = xp[:, 0:s] * w[0]
    for k in range(1, width):
        y = y + xp[:, k:k + s] * w[k]
    return y


def masked_softmax(s, mask):
    s = jnp.where(mask, s.astype(jnp.float32), -jnp.inf)
    m = jnp.max(s, axis=-1, keepdims=True)
    m = jnp.where(jnp.isfinite(m), m, 0.0)
    p = jnp.where(mask, jnp.exp(s - m), 0.0)
    return p / jnp.maximum(jnp.sum(p, axis=-1, keepdims=True), 1e-30)


def compress(kv, pos, w1, b1, w2):
    b, s, h, dh = kv.shape
    n_cmp = (s - CMP_BLOCK) // CMP_STRIDE + 1
    idx = jnp.arange(n_cmp)[:, None] * CMP_STRIDE + jnp.arange(CMP_BLOCK)[None, :]
    blocks = kv[:, idx] + pos[None, None, :, None, :]
    flat = blocks.transpose(0, 3, 1, 2, 4).reshape(b, h, n_cmp, CMP_BLOCK * dh)
    return jax.nn.gelu(flat @ w1 + b1) @ w2


def nsa_mixer(q, kv, gates, pos_k, pos_v, ck_w1, ck_b1, ck_w2, cv_w1, cv_b1, cv_w2):
    b, s = q.shape[:2]
    h, g, dh = NSA_KV_HEADS, NSA_GROUP, NSA_HEAD_DIM
    kv = kv.reshape(b, s, 6, h, dh)
    k_cmp, v_cmp, k_slc, v_slc, k_win, v_win = (kv[:, :, i] for i in range(6))
    kc = compress(k_cmp, pos_k, ck_w1, ck_b1, ck_w2)
    vc = compress(v_cmp, pos_v, cv_w1, cv_b1, cv_w2)
    n_cmp = kc.shape[2]
    n_sb = s // SEL_BLOCK
    top = min(N_SELECT, n_sb)
    cmp_start = jnp.arange(n_cmp) * CMP_STRIDE
    sel_start = jnp.arange(n_sb) * SEL_BLOCK
    overlap = ((cmp_start[:, None] < sel_start[None, :] + SEL_BLOCK)
               & (sel_start[None, :] < cmp_start[:, None] + CMP_BLOCK)).astype(jnp.float32)
    ks_blk = k_slc.reshape(b, n_sb, SEL_BLOCK, h, dh).transpose(0, 3, 1, 2, 4)
    vs_blk = v_slc.reshape(b, n_sb, SEL_BLOCK, h, dh).transpose(0, 3, 1, 2, 4)
    kw_pad = jnp.pad(k_win, ((0, 0), (WINDOW, 0), (0, 0), (0, 0)))
    vw_pad = jnp.pad(v_win, ((0, 0), (WINDOW, 0), (0, 0), (0, 0)))
    qg = q.reshape(b, s, h, g, dh) * (NSA_HEAD_DIM ** -0.5)
    bi = jnp.arange(b)[:, None, None, None]
    hi = jnp.arange(h)[None, :, None, None]
    j_blk = jnp.arange(n_sb)

    def query_block(s0):
        t = s0 + jnp.arange(QUERY_BLOCK)
        qb = lax.dynamic_slice_in_dim(qg, s0, QUERY_BLOCK, axis=1)
        m_cmp = (cmp_start[None, :] + CMP_BLOCK - 1) <= t[:, None]
        p_cmp = masked_softmax(jnp.einsum('bqhgd,bhnd->bhgqn', qb, kc), m_cmp)
        o_cmp = jnp.einsum('bhgqn,bhnd->bqhgd', p_cmp, vc)
        imp = jnp.einsum('bhgqn,nj->bhqj', p_cmp, overlap)
        cur = t // SEL_BLOCK
        valid = sel_start[None, :] <= t[:, None]
        forced = (j_blk[None, :] == 0) | (j_blk[None, :] == cur[:, None]) | (j_blk[None, :] == cur[:, None] - 1)
        score = jnp.where(forced, jnp.inf, jnp.where(valid, imp, -jnp.inf))
        top_val, top_idx = lax.top_k(score, top)
        k_sel = ks_blk[bi, hi, top_idx].reshape(b, h, QUERY_BLOCK, top * SEL_BLOCK, dh)
        v_sel = vs_blk[bi, hi, top_idx].reshape(b, h, QUERY_BLOCK, top * SEL_BLOCK, dh)
        tok = (top_idx[..., None] * SEL_BLOCK + jnp.arange(SEL_BLOCK)).reshape(b, h, QUERY_BLOCK, top * SEL_BLOCK)
        m_sel = jnp.repeat(top_val > -jnp.inf, SEL_BLOCK, axis=-1) & (tok <= t[:, None])
        p_sel = masked_softmax(jnp.einsum('bqhgd,bhqnd->bhgqn', qb, k_sel), m_sel[:, :, None])
        o_sel = jnp.einsum('bhgqn,bhqnd->bqhgd', p_sel, v_sel)
        kw = lax.dynamic_slice_in_dim(kw_pad, s0, WINDOW + QUERY_BLOCK, axis=1)
        vw = lax.dynamic_slice_in_dim(vw_pad, s0, WINDOW + QUERY_BLOCK, axis=1)
        kpos = s0 - WINDOW + jnp.arange(WINDOW + QUERY_BLOCK)
        m_win = (kpos[None, :] >= 0) & (kpos[None, :] <= t[:, None]) & (kpos[None, :] > t[:, None] - WINDOW)
        p_win = masked_softmax(jnp.einsum('bqhgd,bkhd->bhgqk', qb, kw), m_win)
        o_win = jnp.einsum('bhgqk,bkhd->bqhgd', p_win, vw)
        return jnp.stack([o_cmp, o_sel, o_win], axis=-2)

    outs = lax.map(query_block, jnp.arange(s // QUERY_BLOCK) * QUERY_BLOCK)
    o = outs.transpose(1, 0, 2, 3, 4, 5, 6).reshape(b, s, NSA_HEADS, 3, dh)
    gate = jax.nn.sigmoid(gates.astype(jnp.float32).reshape(b, s, NSA_HEADS, 3))
    return jnp.einsum('bshc,bshcd->bshd', gate, o).reshape(b, s, NSA_WIDTH).astype(q.dtype)


def gated_delta_rule_chunked(q, k, v, g, beta):
    b, s, h, dk = q.shape
    dv = v.shape[-1]
    c = GDN_CHUNK
    n = s // c
    chunks = lambda a: a.reshape(b, n, c, h, -1).transpose(1, 0, 3, 2, 4)
    qc, kc, vc = chunks(q), chunks(k), chunks(v)
    gc = g.reshape(b, n, c, h).transpose(1, 0, 3, 2)
    bc = beta.reshape(b, n, c, h).transpose(1, 0, 3, 2)
    gcum = jnp.cumsum(gc, axis=-1)
    tril = jnp.tril(jnp.ones((c, c), dtype=bool))
    strict = jnp.tril(jnp.ones((c, c), dtype=bool), -1)
    decay = jnp.exp(jnp.where(tril, gcum[..., :, None] - gcum[..., None, :], -jnp.inf))
    kb = kc * bc[..., None]
    vb = vc * bc[..., None]
    a_mat = jnp.where(strict, jnp.einsum('nbhid,nbhjd->nbhij', kb, kc) * decay, 0.0)
    eye = jnp.eye(c, dtype=jnp.float32)
    rhs = jnp.concatenate([vb, kb * jnp.exp(gcum)[..., None]], axis=-1)
    sol = lax.linalg.triangular_solve(a_mat + eye, rhs, left_side=True, lower=True, unit_diagonal=True)
    u, w = sol[..., :dv], sol[..., dv:]
    attn = jnp.einsum('nbhid,nbhjd->nbhij', qc, kc) * decay

    def step(state, xs):
        q_i, k_i, u_i, w_i, g_i, a_i = xs
        v_new = u_i - jnp.einsum('bhck,bhkv->bhcv', w_i, state)
        o = (jnp.einsum('bhck,bhkv->bhcv', q_i * jnp.exp(g_i)[..., None], state)
             + jnp.einsum('bhcj,bhjv->bhcv', a_i, v_new))
        g_last = g_i[..., -1:]
        state = (state * jnp.exp(g_last)[..., None]
                 + jnp.einsum('bhck,bhcv->bhkv', k_i * jnp.exp(g_last - g_i)[..., None], v_new))
        return state, o

    state0 = jnp.zeros((b, h, dk, dv), jnp.float32)
    _, o = lax.scan(step, state0, (qc, kc, u, w, gcum, attn))
    return o.transpose(1, 0, 3, 2, 4).reshape(b, s, h, dv)


def gdn_mixer(qkv, z, b_in, a_in, conv_w, a_log, dt_bias, norm_g):
    b, s = qkv.shape[:2]
    h, d = GDN_HEADS, GDN_HEAD_DIM
    qkv = jax.nn.silu(causal_dwconv(qkv, conv_w))
    q, k, v = jnp.split(qkv, 3, axis=-1)
    q = l2norm(q.reshape(b, s, h, d)) * (d ** -0.5)
    k = l2norm(k.reshape(b, s, h, d))
    v = v.reshape(b, s, h, d).astype(jnp.float32)
    beta = jax.nn.sigmoid(b_in.astype(jnp.float32))
    g = -jnp.exp(a_log.astype(jnp.float32)) * jax.nn.softplus(a_in.astype(jnp.float32) + dt_bias.astype(jnp.float32))
    o = gated_delta_rule_chunked(q, k, v, g, beta)
    o = rmsnorm(o, norm_g) * jax.nn.silu(z.reshape(b, s, h, d).astype(jnp.float32))
    return o.reshape(b, s, GDN_WIDTH).astype(z.dtype)


def setup_inputs(seed: int = 0) -> dict:
    key = jax.random.key(seed)
    ks = jax.random.split(key, 24)
    L = DEPTH
    f32 = jnp.float32
    nrm = lambda k, shape, scale: jax.random.normal(k, shape, f32) * scale
    dt = jnp.exp(jax.random.uniform(ks[13], (L, GDN_HEADS), f32, np.log(1e-3), np.log(1e-1)))
    return {
        "x": nrm(ks[0], (BATCH, SEQ, D_MODEL), 1.0),
        "norm_mix": 1.0 + nrm(ks[1], (L, D_MODEL), 0.02),
        "w_in": nrm(ks[2], (L, D_MODEL, IN_WIDTH), D_MODEL ** -0.5),
        "cmp_pos_k": nrm(ks[3], (L, CMP_BLOCK, NSA_HEAD_DIM), 0.1),
        "cmp_pos_v": nrm(ks[4], (L, CMP_BLOCK, NSA_HEAD_DIM), 0.1),
        "cmp_k_w1": nrm(ks[5], (L, CMP_BLOCK * NSA_HEAD_DIM, CMP_HIDDEN), (CMP_BLOCK * NSA_HEAD_DIM) ** -0.5),
        "cmp_k_b1": nrm(ks[6], (L, CMP_HIDDEN), 0.01),
        "cmp_k_w2": nrm(ks[7], (L, CMP_HIDDEN, NSA_HEAD_DIM), CMP_HIDDEN ** -0.5),
        "cmp_v_w1": nrm(ks[8], (L, CMP_BLOCK * NSA_HEAD_DIM, CMP_HIDDEN), (CMP_BLOCK * NSA_HEAD_DIM) ** -0.5),
        "cmp_v_b1": nrm(ks[9], (L, CMP_HIDDEN), 0.01),
        "cmp_v_w2": nrm(ks[10], (L, CMP_HIDDEN, NSA_HEAD_DIM), CMP_HIDDEN ** -0.5),
        "nsa_norm": 1.0 + nrm(ks[11], (L, NSA_WIDTH), 0.02),
        "gdn_conv": nrm(ks[12], (L, GDN_CONV, 3 * GDN_WIDTH), GDN_CONV ** -0.5),
        "gdn_a_log": jnp.log(jax.random.uniform(ks[14], (L, GDN_HEADS), f32, 1.0, 16.0)),
        "gdn_dt_bias": dt + jnp.log(-jnp.expm1(-dt)),
        "gdn_norm": 1.0 + nrm(ks[15], (L, GDN_HEAD_DIM), 0.02),
        "w_out": nrm(ks[16], (L, MIX_WIDTH, D_MODEL), MIX_WIDTH ** -0.5),
        "norm_ffn": 1.0 + nrm(ks[17], (L, D_MODEL), 0.02),
        "ffn_up": nrm(ks[18], (L, D_MODEL, 2 * D_FF), D_MODEL ** -0.5),
        "ffn_conv": nrm(ks[19], (L, FFN_CONV, 2 * D_FF), FFN_CONV ** -0.5),
        "ffn_down": nrm(ks[20], (L, D_FF, D_MODEL), D_FF ** -0.5),
        "norm_final": 1.0 + nrm(ks[21], (D_MODEL,), 0.02),
    }


def reference(x, norm_mix, w_in, cmp_pos_k, cmp_pos_v, cmp_k_w1, cmp_k_b1, cmp_k_w2, cmp_v_w1, cmp_v_b1, cmp_v_w2,
              nsa_norm, gdn_conv, gdn_a_log, gdn_dt_bias, gdn_norm, w_out, norm_ffn, ffn_up, ffn_conv, ffn_down,
              norm_final):
    for l in range(DEPTH):
        h = rmsnorm(x, norm_mix[l])
        proj = h @ w_in[l]
        q_nsa, kv_nsa, gate_nsa, qkv_gdn, z_gdn, b_gdn, a_gdn = jnp.split(proj, SPLIT_POINTS, axis=-1)
        o_nsa = nsa_mixer(q_nsa, kv_nsa, gate_nsa, cmp_pos_k[l], cmp_pos_v[l],
                          cmp_k_w1[l], cmp_k_b1[l], cmp_k_w2[l], cmp_v_w1[l], cmp_v_b1[l], cmp_v_w2[l])
        o_nsa = rmsnorm(o_nsa, nsa_norm[l])
        o_gdn = gdn_mixer(qkv_gdn, z_gdn, b_gdn, a_gdn, gdn_conv[l], gdn_a_log[l], gdn_dt_bias[l], gdn_norm[l])
        x = x + jnp.concatenate([o_nsa, o_gdn], axis=-1) @ w_out[l]
        h = rmsnorm(x, norm_ffn[l])
        u = causal_dwconv(h @ ffn_up[l], ffn_conv[l])
        gate, up = jnp.split(u, 2, axis=-1)
        x = x + (jax.nn.silu(gate) * up) @ ffn_down[l]
    return rmsnorm(x, norm_final)
```

```cpp
#include <hip/hip_runtime.h>
#include <cstdio>
#include <cstdint>
namespace pg8 {
#define PG8_LAS __attribute__((address_space(3)))
typedef unsigned short bf16_t;
typedef short bf16x8 __attribute__((ext_vector_type(8)));
typedef float f32x4 __attribute__((ext_vector_type(4)));
typedef unsigned u32x4 __attribute__((ext_vector_type(4)));
typedef int i32x4v __attribute__((ext_vector_type(4)));
typedef int i32x8v __attribute__((ext_vector_type(8)));
constexpr int BM = 256, BK = 64, HALF = 128, HTB = HALF * BK * 2  , STAGE_BYTES = 8 * HTB, NXCD = 8, WGM = 8;

__host__ __device__ __forceinline__ int lds_byte(int r, int c) { const int st = (r >> 4) * 2 + (c >> 5), rr = r & 15, cc = c & 31, ob = rr * 64 + cc * 2; return st * 1024 + (ob ^ (((ob >> 9) & 1) << 5)); }
__host__ __device__ __forceinline__ void stage_rc(int b, int& R, int& C) { const int st = b / 1024, sb = b % 1024, swz = sb ^ (((sb >> 9) & 1) << 5); R = (st >> 1) * 16 + swz / 64; C = (st & 1) * 32 + (swz % 64) / 2; }
__host__ __device__ __forceinline__ int perm32(int rho) { const int n = rho >> 4, i = rho & 15; return 8 * (i >> 2) + 4 * n + (i & 3); }

struct Unit { int pm, pn; };
struct Gemm { const bf16_t* A; const bf16_t* Bt; int M, N, K; };

struct StaticOrder {
    int nM, nN, nwg, G, c;
    __host__ __device__ void init(int M, int N, int G_, int c_) { nM = M / BM; nN = N / BM; nwg = nM * nN; G = G_; c = c_; }
    __host__ __device__ bool next(int i, Unit& u) const {
        const long L = (long)i * G + c; if (L >= nwg) return false;
        int wgid = (int)L; { const int q = nwg / NXCD, r = nwg % NXCD, xcd = wgid % NXCD, off = wgid / NXCD; wgid = (xcd < r ? xcd * (q + 1) : r * (q + 1) + (xcd - r) * q) + off; }
        const int nig = WGM * nN, gid = wgid / nig, fm = gid * WGM, gsz = (nM - fm) < WGM ? (nM - fm) : WGM;
        u.pm = fm + ((wgid % nig) % gsz); u.pn = (wgid % nig) / gsz; return true;
    }
    __device__ __forceinline__ void a_ready(const Unit&) const {}
    __device__ __forceinline__ void done(const Unit&) const {}
};

__device__ __forceinline__ unsigned pk4_fp8(float a, float b, float c, float d) {
    a = __builtin_fminf(__builtin_fmaxf(a, -448.f), 448.f); b = __builtin_fminf(__builtin_fmaxf(b, -448.f), 448.f); c = __builtin_fminf(__builtin_fmaxf(c, -448.f), 448.f); d = __builtin_fminf(__builtin_fmaxf(d, -448.f), 448.f);
    int p = __builtin_amdgcn_cvt_pk_fp8_f32(a, b, 0, false); p = __builtin_amdgcn_cvt_pk_fp8_f32(c, d, p, true); return (unsigned)p; }
__device__ __forceinline__ unsigned cvt_pk_bf16(float lo, float hi) { unsigned r; asm volatile("v_cvt_pk_bf16_f32 %0, %1, %2" : "=v"(r) : "v"(lo), "v"(hi)); return r; }

template <class Epi, class Sched, bool ALIGN_EPI = false, bool SP2 = false, bool F8 = false, bool APERM = false>
__device__ __forceinline__ void gemm_phase(PG8_LAS unsigned char* lds, const Gemm g, const Sched& S, const Epi& E, const int wv) {
    int tid_ = wv * 64 + (int)__builtin_amdgcn_mbcnt_hi(~0u, __builtin_amdgcn_mbcnt_lo(~0u, 0u)); asm volatile("" : "+v"(tid_));
    const int tid = tid_, wid = __builtin_amdgcn_readfirstlane(tid >> 6), lane = tid & 63, wr = wid >> 2, wc = wid & 3, fr = lane & 15, fq = lane >> 4;
    const int K = g.K, pitch = F8 ? K : 2 * K  , nt = pitch / (BK * 2);
    unsigned voffA[2], voffB[2];
#pragma unroll
    for (int i = 0; i < 2; ++i) { int R, C; stage_rc(tid * 16 + i * 8192, R, C); const int Rb = Epi::PERM ? ((R & ~31) + perm32(R & 31)) : R;
        const int Ra = APERM ? ((R & ~63) | ((R & 15) << 2) | ((R >> 4) & 3)) : R; voffA[i] = (unsigned)(Ra * pitch + C * 2); voffB[i] = (unsigned)(Rb * pitch + C * 2); }
    const size_t kstep = (size_t)(BK * 2);
    const size_t hstep = (size_t)HALF * pitch;
    const size_t tstep = 2 * hstep;
    const unsigned ldsw = (unsigned)wid * 1024u;
    const int aoff = lds_byte(wr * 64 + fr, fq * 8), boff = lds_byte(wc * 32 + fr, fq * 8);
#define PG8_SA(b, h) (((b) * 2 + (h)) * HTB)
#define PG8_SB(b, h) ((4 + (b) * 2 + (h)) * HTB)
#define PG8_STAGE(bufoff, gbase, voff) do { _Pragma("unroll") for (int _i = 0; _i < 2; ++_i) \
        __builtin_amdgcn_global_load_lds((const unsigned*)((const char*)(gbase) + (voff)[_i]), (PG8_LAS unsigned*)(lds + (bufoff) + ldsw + _i * 8192), 16, 0, 0); } while (0)
#define PG8_LDA(dst, b, h) do { _Pragma("unroll") for (int m = 0; m < 4; ++m) _Pragma("unroll") for (int k = 0; k < 2; ++k) dst[m][k] = *(const PG8_LAS bf16x8*)(lds + PG8_SA(b, h) + aoff + m * 2048 + k * 1024); } while (0)
#define PG8_LDB(dst, b, h) do { _Pragma("unroll") for (int n = 0; n < 2; ++n) _Pragma("unroll") for (int k = 0; k < 2; ++k) dst[n][k] = *(const PG8_LAS bf16x8*)(lds + PG8_SB(b, h) + boff + n * 2048 + k * 1024); } while (0)
#define PG8_CAT8(x, y) __builtin_shufflevector(__builtin_bit_cast(i32x4v, x), __builtin_bit_cast(i32x4v, y), 0, 1, 2, 3, 4, 5, 6, 7)
#define PG8_MMA(ai, bj, At, Bt) do { __builtin_amdgcn_s_setprio(1); _Pragma("unroll") for (int m = 0; m < 4; ++m) _Pragma("unroll") for (int n = 0; n < 2; ++n) { \
        if constexpr (F8) asm volatile("v_mfma_scale_f32_16x16x128_f8f6f4 %0, %1, %2, %0, %3, %3 op_sel_hi:[0,0,0]" : "+v"(acc[ai][bj][m][n]) : "v"(PG8_CAT8(Bt[n][0], Bt[n][1])), "v"(PG8_CAT8(At[m][0], At[m][1])), "v"(scl8)); \
        else { _Pragma("unroll") for (int k = 0; k < 2; ++k) acc[ai][bj][m][n] = __builtin_amdgcn_mfma_f32_16x16x32_bf16(Bt[n][k], At[m][k], acc[ai][bj][m][n], 0, 0, 0); } } __builtin_amdgcn_s_setprio(0); } while (0)
#define PG8_WAIT_V(n) asm volatile("s_waitcnt vmcnt(" #n ")" ::: "memory")
#define PG8_WAIT_L(n) asm volatile("s_waitcnt lgkmcnt(" #n ")" ::: "memory")
#define PG8_BAR __builtin_amdgcn_s_barrier()
#define PG8_SCHED __builtin_amdgcn_sched_barrier(0)
    Unit cur, nxt; int ui = 0;
    int scl8 = 0x7f7f7f7f; asm volatile("" : "+v"(scl8));
    if (!S.next(0, cur)) return;
    f32x4 acc[2][2][4][2];
#pragma unroll
    for (int a = 0; a < 2; ++a)
#pragma unroll
        for (int b = 0; b < 2; ++b)
#pragma unroll
            for (int m = 0; m < 4; ++m)
#pragma unroll
                for (int n = 0; n < 2; ++n) acc[a][b][m][n] = (f32x4){0.f, 0.f, 0.f, 0.f};
    bf16x8 At[4][2], B0[2][2], B1[2][2];
    const char* cA = (const char*)g.A + (size_t)cur.pm * tstep; const char* cB = (const char*)g.Bt + (size_t)cur.pn * tstep;
    S.a_ready(cur);
    if constexpr (SP2) {
        PG8_STAGE(PG8_SB(0, 0), cB, voffB); PG8_STAGE(PG8_SB(0, 1), cB + hstep, voffB); PG8_STAGE(PG8_SA(0, 0), cA, voffA); PG8_STAGE(PG8_SA(0, 1), cA + hstep, voffA);
        if (wr == 1) PG8_BAR;
        PG8_WAIT_V(2); PG8_BAR;
        PG8_STAGE(PG8_SB(1, 0), cB + kstep, voffB); PG8_STAGE(PG8_SA(1, 0), cA + kstep, voffA); PG8_STAGE(PG8_SB(1, 1), cB + hstep + kstep, voffB);
        PG8_WAIT_V(6); PG8_BAR;
    } else {
        PG8_STAGE(PG8_SB(0, 0), cB, voffB); PG8_STAGE(PG8_SA(0, 0), cA, voffA); PG8_STAGE(PG8_SB(0, 1), cB + hstep, voffB); PG8_STAGE(PG8_SA(0, 1), cA + hstep, voffA);
        if (wr == 1) PG8_BAR;
        PG8_WAIT_V(4); PG8_BAR;
        PG8_STAGE(PG8_SB(1, 0), cB + kstep, voffB); PG8_STAGE(PG8_SA(1, 0), cA + kstep, voffA); PG8_STAGE(PG8_SB(1, 1), cB + hstep + kstep, voffB);
        PG8_WAIT_V(6); PG8_BAR;
    }
    for (;;) {
        const bool has_next = S.next(ui + 1, nxt);
        const char* nA = has_next ? (const char*)g.A + (size_t)nxt.pm * tstep : cA; const char* nB = has_next ? (const char*)g.Bt + (size_t)nxt.pn * tstep : cB;
        for (int t = 0; t < nt; t += 2) {
            const bool last = (t == nt - 2);
            const char* a1 = cA + (size_t)(t + 1) * kstep;
            const char* a2 = last ? nA : cA + (size_t)(t + 2) * kstep; const char* b2 = last ? nB : cB + (size_t)(t + 2) * kstep;
            const char* a3 = a2 + kstep; const char* b3 = b2 + kstep;
            if (last && has_next) S.a_ready(nxt);
            if constexpr (SP2) {
            PG8_LDB(B0, 0, 0); PG8_LDB(B1, 0, 1); PG8_SCHED; PG8_LDA(At, 0, 0); PG8_STAGE(PG8_SA(1, 1), a1 + hstep, voffA);
            PG8_WAIT_V(8); PG8_WAIT_L(0); PG8_BAR; PG8_MMA(0, 0, At, B0); PG8_MMA(0, 1, At, B1); PG8_BAR; PG8_SCHED;
            PG8_LDA(At, 0, 1); PG8_STAGE(PG8_SB(0, 0), b2, voffB); PG8_STAGE(PG8_SB(0, 1), b2 + hstep, voffB); PG8_STAGE(PG8_SA(0, 0), a2, voffA);
            PG8_WAIT_V(8); PG8_WAIT_L(0); PG8_BAR; PG8_MMA(1, 0, At, B0); PG8_MMA(1, 1, At, B1); PG8_BAR; PG8_SCHED;
            PG8_LDB(B0, 1, 0); PG8_LDB(B1, 1, 1); PG8_SCHED; PG8_LDA(At, 1, 0); PG8_STAGE(PG8_SA(0, 1), a2 + hstep, voffA);
            PG8_WAIT_V(8); PG8_WAIT_L(0); PG8_BAR; PG8_MMA(0, 0, At, B0); PG8_MMA(0, 1, At, B1); PG8_BAR; PG8_SCHED;
            PG8_LDA(At, 1, 1); PG8_STAGE(PG8_SB(1, 0), b3, voffB); PG8_STAGE(PG8_SB(1, 1), b3 + hstep, voffB); PG8_STAGE(PG8_SA(1, 0), a3, voffA);
            PG8_WAIT_V(8); PG8_WAIT_L(0); PG8_BAR; PG8_MMA(1, 0, At, B0); PG8_MMA(1, 1, At, B1); PG8_BAR; PG8_SCHED;
            } else {
            PG8_LDB(B0, 0, 0); PG8_SCHED; PG8_LDA(At, 0, 0); PG8_STAGE(PG8_SA(1, 1), a1 + hstep, voffA);
            PG8_WAIT_L(8); PG8_BAR; PG8_WAIT_L(0); PG8_MMA(0, 0, At, B0); PG8_BAR; PG8_SCHED;
            PG8_LDB(B1, 0, 1); PG8_STAGE(PG8_SB(0, 0), b2, voffB);
            PG8_BAR; PG8_WAIT_L(0); PG8_MMA(0, 1, At, B1); PG8_BAR;
            PG8_LDA(At, 0, 1); PG8_STAGE(PG8_SA(0, 0), a2, voffA);
            PG8_BAR; PG8_WAIT_L(0); PG8_MMA(1, 0, At, B0); PG8_BAR; PG8_SCHED;
            PG8_STAGE(PG8_SB(0, 1), b2 + hstep, voffB);
            PG8_WAIT_V(6); PG8_BAR; PG8_MMA(1, 1, At, B1); PG8_BAR;
            PG8_LDB(B0, 1, 0); PG8_SCHED; PG8_LDA(At, 1, 0); PG8_STAGE(PG8_SA(0, 1), a2 + hstep, voffA);
            PG8_WAIT_L(8); PG8_BAR; PG8_WAIT_L(0); PG8_MMA(0, 0, At, B0); PG8_BAR; PG8_SCHED;
            PG8_LDB(B1, 1, 1); PG8_STAGE(PG8_SB(1, 0), b3, voffB);
            PG8_BAR; PG8_WAIT_L(0); PG8_MMA(0, 1, At, B1); PG8_BAR;
            PG8_LDA(At, 1, 1); PG8_STAGE(PG8_SA(1, 0), a3, voffA);
            PG8_BAR; PG8_WAIT_L(0); PG8_MMA(1, 0, At, B0); PG8_BAR; PG8_SCHED;
            PG8_STAGE(PG8_SB(1, 1), b3 + hstep, voffB);
            PG8_WAIT_V(6); PG8_BAR; PG8_MMA(1, 1, At, B1); PG8_BAR;
            }
        }
        if constexpr (ALIGN_EPI) { if (wr == 0) PG8_BAR; }
        if constexpr (F8) asm volatile("s_nop 15\n\ts_nop 7" ::: "memory");
        if constexpr (!Epi::AFTER_DRAIN) { E(acc, cur, wr, wc, fr, fq); S.done(cur); }
        if (!has_next) break;
#pragma unroll
        for (int a = 0; a < 2; ++a)
#pragma unroll
            for (int b = 0; b < 2; ++b)
#pragma unroll
                for (int m = 0; m < 4; ++m)
#pragma unroll
                    for (int n = 0; n < 2; ++n) acc[a][b][m][n] = (f32x4){0.f, 0.f, 0.f, 0.f};
        cur = nxt; cA = nA; cB = nB; ++ui;
        if constexpr (ALIGN_EPI) { if (wr == 1) PG8_BAR; }
    }
    PG8_WAIT_V(0);
    if constexpr (!ALIGN_EPI) { if (wr == 0) PG8_BAR; }
    PG8_BAR;
    if constexpr (Epi::AFTER_DRAIN) { E.fused(acc, cur, wr, wc, fr, fq, lds, wid, lane); S.done(cur); }
#undef PG8_SA
#undef PG8_SB
#undef PG8_STAGE
#undef PG8_LDA
#undef PG8_LDB
#undef PG8_MMA
#undef PG8_CAT8
#undef PG8_WAIT_V
#undef PG8_WAIT_L
#undef PG8_BAR
#undef PG8_SCHED
}
}

constexpr int NB = 32, SEQ = 2048, DM = 1024, MTOK = NB * SEQ, NLAYER = 2;
constexpr int HQ = 8, HKV = 2, DH = 64;
constexpr int GH = 4, GD = 128;
constexpr int INW = 3360, INA = 2304, INB = 1280, FF = 2816, FF2 = 5632;
constexpr float EPS = 1e-6f;
constexpr float QSCALE = 0.125f * 1.4426950408889634f;
constexpr int NWAVES = 8;

constexpr size_t MiB = 1u << 20;
constexpr size_t WS_CTL = 0, CTL_ZERO_BYTES = 1 * MiB;
constexpr size_t WS_WTS = 2 * MiB, WTS_LAYER = 30 * MiB;
constexpr size_t WO_IN = 0, WO_OUT = 7 * MiB, WO_UP = 9 * MiB, WO_DN = 20 * MiB, WO_W1K = 26 * MiB, WO_W1V = 27 * MiB, WO_MISC = 28 * MiB;
constexpr size_t WS_H = 65 * MiB;
constexpr size_t WS_H8 = 193 * MiB;
constexpr size_t WS_H8B = 741 * MiB;
constexpr size_t KV_PIECE_BYTES = (size_t)32 * 2 * 2048 * 64 * 2;
constexpr size_t WS_Q = 193 * MiB;
constexpr size_t WS_KV = 257 * MiB;
constexpr size_t WS_G = 353 * MiB;
constexpr size_t WS_Z = 545 * MiB;
constexpr size_t WS_SM = 609 * MiB;
constexpr size_t WS_GP = 613 * MiB;
constexpr size_t WS_MIX = 613 * MiB;
constexpr size_t WS_P = 901 * MiB;
constexpr size_t WS_KC = 917 * MiB;
constexpr size_t WS_ACT = 545 * MiB;
constexpr size_t WS_GL = 919 * MiB;
constexpr size_t WS_SSQ = 920 * MiB;
constexpr size_t WS_FB = 936 * MiB, WS_HB = 948 * MiB;
constexpr size_t WS_END = 960 * MiB;
static_assert(WS_ACT + (size_t)MTOK * FF * 2 <= WS_P, "ACT overlays Z .. GP");
constexpr int CW_BAR = 4096;
constexpr int CW_B1P = 16384;

constexpr int LDS_BYTES = 160 * 1024;
constexpr int MISC_OFF = 159 * 1024;

#define GAS __attribute__((address_space(1)))
#define LAS __attribute__((address_space(3)))
typedef unsigned short bf16;
typedef unsigned v4u __attribute__((ext_vector_type(4)));
typedef float f32x4 __attribute__((ext_vector_type(4)));
#define LDS_WAIT() asm volatile("s_waitcnt lgkmcnt(0)" ::: "memory")
#define VM_WAIT() asm volatile("s_waitcnt vmcnt(0)" ::: "memory")
typedef float f32x2c_t __attribute__((ext_vector_type(2))); typedef __bf16 bf16x2c_t __attribute__((ext_vector_type(2)));
__device__ __forceinline__ unsigned pk2(float lo, float hi) { const f32x2c_t v = {lo, hi}; return __builtin_bit_cast(unsigned, __builtin_convertvector(v, bf16x2c_t)); }
__device__ __forceinline__ unsigned f2bf(float f) { return pk2(f, 0.f) & 0xffffu; }
__device__ __forceinline__ float bf2f(bf16 v) { return __uint_as_float(((unsigned)v) << 16); }
__device__ __forceinline__ float bflo(unsigned u) { return __uint_as_float(u << 16); }
__device__ __forceinline__ float bfhi(unsigned u) { return __uint_as_float(u & 0xffff0000u); }
__device__ __forceinline__ float wave_sum(float v) {
#pragma unroll
    for (int o = 1; o < 64; o <<= 1) v += __shfl_xor(v, o);
    return v;
}
__device__ __forceinline__ float wave_max(float v) {
#pragma unroll
    for (int o = 1; o < 64; o <<= 1) v = fmaxf(v, __shfl_xor(v, o));
    return v;
}
__device__ __forceinline__ float siluf(float x) { return x * __builtin_amdgcn_rcpf(1.0f + __expf(-x)); }
__device__ __forceinline__ float sigmf(float x) { return __builtin_amdgcn_rcpf(1.0f + __expf(-x)); }
__device__ __forceinline__ float softplusf(float x) { return fmaxf(x, 0.f) + log1pf(__expf(-fabsf(x))); }
__device__ __forceinline__ float gelu_tanh(float x) { const float y = 0.7978845608028654f * (x + 0.044715f * x * x * x); const float th = 1.0f - 2.0f / (__expf(2.0f * y) + 1.0f); return 0.5f * x * (1.0f + th); }

#define XB_TMO      128
#define XB_XCNT(j)  (256  + 64 * (j))
#define XB_XSUB(j)  (1280 + 64 * (j))
#define XB_XGEN(j)  (2304 + 64 * (j))
#define XB_TOP      3328
#define XB_TOPGEN   3392
#define XCD_BAR_WORDS 3456
#define XB_SPIN_CAP (1u << 22)
__device__ __forceinline__ unsigned xb_ld(unsigned* p)              { return __hip_atomic_load(p, __ATOMIC_RELAXED, __HIP_MEMORY_SCOPE_AGENT); }
__device__ __forceinline__ unsigned xb_add(unsigned* p, unsigned v) { return __hip_atomic_fetch_add(p, v, __ATOMIC_RELAXED, __HIP_MEMORY_SCOPE_AGENT); }
__device__ __forceinline__ unsigned xb_xcc_id() { return (unsigned)__builtin_amdgcn_s_getreg((3 << 11) | 20) & 0xFu; }
#define XB_SPIN(cond, bar) do { unsigned _sp = 0; while (cond) { __builtin_amdgcn_s_sleep(1); \
    if ((++_sp & 255u) == 0u) { if (xb_ld(&(bar)[XB_TMO])) break; if (_sp > XB_SPIN_CAP) { atomicAdd(&(bar)[XB_TMO], 1u); break; } } } } while (0)
struct XcdBarrier { unsigned* bar; unsigned x; volatile LAS unsigned* st; };
__device__ __forceinline__ XcdBarrier xcd_barrier_post(unsigned* bar, volatile LAS unsigned* st, const bool t0) {
    XcdBarrier b; b.bar = bar; b.x = xb_xcc_id(); b.st = st;
    if (t0) (void)xb_add(&bar[XB_XCNT(b.x)], 1u);
    return b;
}
__device__ __forceinline__ void xcd_barrier_complete(unsigned* bar, unsigned x, unsigned& nloc, unsigned& nx) {
    const unsigned G = gridDim.x * gridDim.y * gridDim.z;
    unsigned sum, cnt, mine, sp = 0u;
    for (;;) {
        sum = 0u; cnt = 0u; mine = 0u;
#pragma unroll
        for (unsigned j = 0; j < 16; ++j) { const unsigned c = xb_ld(&bar[XB_XCNT(j)]); sum += c; cnt += (c > 0u) ? 1u : 0u; mine = (j == x) ? c : mine; }
        if (sum == G) break;
        __builtin_amdgcn_s_sleep(1);
        if ((++sp & 255u) == 0u) { if (xb_ld(&bar[XB_TMO])) break; if (sp > XB_SPIN_CAP) { atomicAdd(&bar[XB_TMO], 1u); break; } }
    }
    nloc = mine > 0u ? mine : 1u; nx = cnt > 0u ? cnt : 1u;
}
__device__ __forceinline__ void xcd_barrier(const XcdBarrier& b, const bool t0) {
    asm volatile("s_waitcnt vmcnt(0)" ::: "memory");
    __syncthreads();
    if (t0) {
        unsigned* bar = b.bar;
        __builtin_amdgcn_s_waitcnt(0);
        unsigned nloc = b.st[0], nx = b.st[1];
        if (nloc == 0u) { xcd_barrier_complete(bar, b.x, nloc, nx); b.st[0] = nloc; b.st[1] = nx; }
        const unsigned old = xb_add(&bar[XB_XSUB(b.x)], 1u);
        const unsigned gen = old / nloc;
        if (old + 1u == (gen + 1u) * nloc) {
            __builtin_amdgcn_fence(__ATOMIC_RELEASE, "agent");
            asm volatile("s_waitcnt vmcnt(0)" ::: "memory");
            const unsigned og = xb_add(&bar[XB_TOP], 1u);
            const unsigned tg = og / nx;
            if (og + 1u == (tg + 1u) * nx) xb_add(&bar[XB_TOPGEN], 1u);
            else XB_SPIN(xb_ld(&bar[XB_TOPGEN]) == tg, bar);
            __builtin_amdgcn_fence(__ATOMIC_ACQUIRE, "agent");
            xb_add(&bar[XB_XGEN(b.x)], 1u);
            asm volatile("s_waitcnt vmcnt(0)" ::: "memory");
        } else {
            XB_SPIN(xb_ld(&bar[XB_XGEN(b.x)]) == gen, bar);
            __builtin_amdgcn_fence(__ATOMIC_ACQUIRE, "agent");
            asm volatile("s_waitcnt vmcnt(0)" ::: "memory");
        }
    }
    __syncthreads();
}

namespace pg8 {
__device__ __forceinline__ float row_rstd(const float* ssqp, int row) {
    const f32x4* p = (const f32x4*)(ssqp + (size_t)row * 16); const f32x4 a = p[0], b = p[1], c = p[2], d = p[3];
    const float s = ((a[0] + a[1]) + (a[2] + a[3])) + ((b[0] + b[1]) + (b[2] + b[3])) + ((c[0] + c[1]) + (c[2] + c[3])) + ((d[0] + d[1]) + (d[2] + d[3]));
    return 1.0f / sqrtf(s * (1.0f / 1024.0f) + 1e-6f); }
__device__ __forceinline__ void rows_rstd(const float* ssqp, int row0, int fq, float (&rs)[2][4], int mstride = 16) {
    f32x4 a[2][4];
#pragma unroll
    for (int ai = 0; ai < 2; ++ai)
#pragma unroll
        for (int m = 0; m < 4; ++m) a[ai][m] = *(const f32x4*)(ssqp + (size_t)(row0 + ai * HALF + m * mstride) * 16 + fq * 4);
#pragma unroll
    for (int ai = 0; ai < 2; ++ai)
#pragma unroll
        for (int m = 0; m < 4; ++m) { float s = (a[ai][m][0] + a[ai][m][1]) + (a[ai][m][2] + a[ai][m][3]); s += __shfl_xor(s, 16); s += __shfl_xor(s, 32); rs[ai][m] = 1.0f / sqrtf(s * (1.0f / 1024.0f) + 1e-6f); }
}
template <bool SCALE, int GRP> struct EpiIn {
    static constexpr bool PERM = true, AFTER_DRAIN = false;
    bf16_t *Q, *KV, *G, *Z, *SM; const float* ssq; mutable int last_pm; PG8_LAS f32x4* rcache;
    float post;
    __device__ __forceinline__ void operator()(const f32x4 (&acc)[2][2][4][2], const Unit& u, int wr, int wc, int fr, int fq) const {
        const int row0 = u.pm * BM + wr * 64 + fr; const int pn = u.pn;
        float rs[2][4];
        if (SCALE) { PG8_LAS f32x4* rc = rcache + 2 * ((wr * 4 + wc) * 64 + (fq * 16 + (fr & 15)));
            if (u.pm != last_pm) { rows_rstd(ssq, row0, fq, rs); last_pm = u.pm; rc[0] = (f32x4){rs[0][0], rs[0][1], rs[0][2], rs[0][3]}; rc[1] = (f32x4){rs[1][0], rs[1][1], rs[1][2], rs[1][3]}; }
            else { const f32x4 a_ = rc[0], b_ = rc[1]; rs[0][0] = a_[0]; rs[0][1] = a_[1]; rs[0][2] = a_[2]; rs[0][3] = a_[3]; rs[1][0] = b_[0]; rs[1][1] = b_[1]; rs[1][2] = b_[2]; rs[1][3] = b_[3]; } }
#pragma unroll
        for (int ai = 0; ai < 2; ++ai)
#pragma unroll
            for (int m = 0; m < 4; ++m) {
                const int row = row0 + ai * HALF + m * 16;
                const float rsr = (SCALE ? rs[ai][m] : 1.0f) * (GRP == 1 ? post : 1.0f);
#pragma unroll
                for (int bj = 0; bj < 2; ++bj) {
                    const int col = pn * BM + bj * HALF + wc * 32 + 8 * fq, c128 = wc * 32 + 8 * fq;
                    const f32x4 v0 = acc[ai][bj][m][0] * rsr, v1 = acc[ai][bj][m][1] * rsr;
                    u32x4 w; w.x = cvt_pk_bf16(v0[0], v0[1]); w.y = cvt_pk_bf16(v0[2], v0[3]); w.z = cvt_pk_bf16(v1[0], v1[1]); w.w = cvt_pk_bf16(v1[2], v1[3]);
                    bf16_t* dst; const int b = row >> 11, sq = row & 2047, hh = (c128 >> 6) & 1, d = c128 & 63;
#define EPIIN_KV(piece) (KV + ((size_t)(((piece) * 32 + b) * 2 + hh) * 2048 + sq) * 64 + d)
#define EPIIN_VT8(piece) do { const int key_ = sq & 63, k32_ = key_ & 31, pos_ = 32 * ((k32_ >> 2) & 1) + 16 * (key_ >> 5) + (k32_ & 3) + 4 * (k32_ >> 3); \
                        unsigned char* vt_ = (unsigned char*)KV + (size_t)(piece) * KV_PIECE_BYTES + ((size_t)(b * 2 + hh) * 2048) * 64 + (size_t)(sq >> 6) * 4096 + d * 64 + pos_; \
                        const unsigned qa_ = pk4_fp8(v0[0] * 4.f, v0[1] * 4.f, v0[2] * 4.f, v0[3] * 4.f), qb_ = pk4_fp8(v1[0] * 4.f, v1[1] * 4.f, v1[2] * 4.f, v1[3] * 4.f); \
                        vt_[0] = (unsigned char)qa_; vt_[64] = (unsigned char)(qa_ >> 8); vt_[128] = (unsigned char)(qa_ >> 16); vt_[192] = (unsigned char)(qa_ >> 24); \
                        vt_[256] = (unsigned char)qb_; vt_[320] = (unsigned char)(qb_ >> 8); vt_[384] = (unsigned char)(qb_ >> 16); vt_[448] = (unsigned char)(qb_ >> 24); } while (0)
#define EPIIN_K8(piece) do { typedef unsigned u32x2_t __attribute__((ext_vector_type(2))); u32x2_t q8_; q8_.x = pk4_fp8(v0[0] * 4.f, v0[1] * 4.f, v0[2] * 4.f, v0[3] * 4.f); q8_.y = pk4_fp8(v1[0] * 4.f, v1[1] * 4.f, v1[2] * 4.f, v1[3] * 4.f); \
                        *(u32x2_t*)((unsigned char*)KV + (size_t)(piece) * KV_PIECE_BYTES + ((size_t)((b * 2 + hh) * 2048 + sq)) * 64 + 32 * ((d >> 3) & 1) + 8 * (d >> 4)) = q8_; } while (0)
                    if (GRP == 0) {
                        if (pn < 2) dst = Q + (size_t)row * 512 + col;
                        else if (pn == 2) { if (bj == 0) dst = EPIIN_KV(0);
                            else { if (c128 >= 32) continue; dst = SM + (size_t)row * 32 + c128; } }
                        else if (pn < 7) dst = G + (size_t)row * 1536 + (col - 768);
                        else dst = Z + (size_t)row * 512 + (col - 1792);
                    } else {
                        if (pn == 0) { if (bj) { EPIIN_VT8(3); continue; } dst = EPIIN_KV(1); }
                        else if (pn == 1) { if (bj) { EPIIN_K8(2); } else { EPIIN_VT8(5); } continue; }
                        else if (pn == 2) { if (bj) continue; EPIIN_K8(4); continue; }
                        else dst = G + (size_t)row * 1536 + 1024 + (col - 768);
                    }
#undef EPIIN_KV
#undef EPIIN_K8
#undef EPIIN_VT8
                    *(u32x4*)dst = w;
                }
            }
    }
};
struct EpiRes {
    static constexpr bool PERM = false, AFTER_DRAIN = false;
    const float* res; float* out; int ldc;
    __device__ __forceinline__ void operator()(const f32x4 (&acc)[2][2][4][2], const Unit& u, int wr, int wc, int fr, int fq) const {
        const int row0 = u.pm * BM + wr * 64 + fr, col0 = u.pn * BM + wc * 32 + 4 * fq;
#pragma unroll
        for (int ai = 0; ai < 2; ++ai)
#pragma unroll
            for (int m = 0; m < 4; ++m) { const size_t off = (size_t)(row0 + ai * HALF + m * 16) * ldc + col0;
#pragma unroll
                for (int bj = 0; bj < 2; ++bj)
#pragma unroll
                    for (int n = 0; n < 2; ++n) { const size_t o = off + bj * HALF + n * 16; *(f32x4*)(out + o) = *(const f32x4*)(res + o) + acc[ai][bj][m][n]; } }
    }
};
template <bool SCALE> struct EpiPlain {
    static constexpr bool PERM = true, AFTER_DRAIN = false;
    bf16_t* O; int ldc; const float* ssq;
    __device__ __forceinline__ void operator()(const f32x4 (&acc)[2][2][4][2], const Unit& u, int wr, int wc, int fr, int fq) const {
        const int row0 = u.pm * BM + wr * 64 + fr, col0 = u.pn * BM + wc * 32 + 8 * fq;
        float rsa[2][4];
        if (SCALE) rows_rstd(ssq, row0, fq, rsa);
#pragma unroll
        for (int ai = 0; ai < 2; ++ai)
#pragma unroll
            for (int m = 0; m < 4; ++m) { bf16_t* rowp = O + (size_t)(row0 + ai * HALF + m * 16) * ldc + col0;
                const float rs = SCALE ? rsa[ai][m] : 1.0f;
#pragma unroll
                for (int bj = 0; bj < 2; ++bj) { const f32x4 v0 = acc[ai][bj][m][0] * rs, v1 = acc[ai][bj][m][1] * rs;
                    u32x4 w; w.x = cvt_pk_bf16(v0[0], v0[1]); w.y = cvt_pk_bf16(v0[2], v0[3]); w.z = cvt_pk_bf16(v1[0], v1[1]); w.w = cvt_pk_bf16(v1[2], v1[3]);
                    *(u32x4*)(rowp + bj * HALF) = w; } }
    }
};
template <bool RES_F32, bool W8 = false> struct EpiResSq {
    static constexpr bool PERM = true, AFTER_DRAIN = false;
    const void* res; bf16_t* hb; float* ssq; unsigned char* h8; float cs;
    __device__ __forceinline__ void operator()(const f32x4 (&acc)[2][2][4][2], const Unit& u, int wr, int wc, int fr, int fq) const {
        const int row0 = u.pm * BM + wr * 64 + fr, col0 = u.pn * BM + wc * 32 + 8 * fq;
        constexpr int MB = RES_F32 ? 2 : 4;
#pragma unroll
        for (int ai = 0; ai < 2; ++ai)
#pragma unroll
            for (int mb = 0; mb < 4; mb += MB) {
                u32x4 rbv[MB][2]; f32x4 rfv[MB][2][2];
#pragma unroll
                for (int mm = 0; mm < MB; ++mm)
#pragma unroll
                    for (int bj = 0; bj < 2; ++bj) { const size_t o = (size_t)(row0 + ai * HALF + (mb + mm) * 16) * 1024 + col0 + bj * HALF;
                        if (RES_F32) { rfv[mm][bj][0] = *(const f32x4*)((const float*)res + o); rfv[mm][bj][1] = *(const f32x4*)((const float*)res + o + 4); }
                        else rbv[mm][bj] = *(const u32x4*)((const bf16_t*)res + o); }
                __builtin_amdgcn_sched_barrier(0);
#pragma unroll
                for (int mm = 0; mm < MB; ++mm) { const int m = mb + mm, row = row0 + ai * HALF + m * 16; float ss = 0.f;
#pragma unroll
                    for (int bj = 0; bj < 2; ++bj) { const size_t o = (size_t)row * 1024 + col0 + bj * HALF;
                        f32x4 r0, r1;
                        if (RES_F32) { r0 = rfv[mm][bj][0]; r1 = rfv[mm][bj][1]; }
                        else { const u32x4 rb = rbv[mm][bj];
                            r0 = (f32x4){__uint_as_float(rb.x << 16), __uint_as_float(rb.x & 0xffff0000u), __uint_as_float(rb.y << 16), __uint_as_float(rb.y & 0xffff0000u)};
                            r1 = (f32x4){__uint_as_float(rb.z << 16), __uint_as_float(rb.z & 0xffff0000u), __uint_as_float(rb.w << 16), __uint_as_float(rb.w & 0xffff0000u)}; }
                        const f32x4 v0 = r0 + acc[ai][bj][m][0] * cs, v1 = r1 + acc[ai][bj][m][1] * cs;
                        ss += (v0[0] * v0[0] + v0[1] * v0[1]) + (v0[2] * v0[2] + v0[3] * v0[3]) + (v1[0] * v1[0] + v1[1] * v1[1]) + (v1[2] * v1[2] + v1[3] * v1[3]);
                        u32x4 w; w.x = cvt_pk_bf16(v0[0], v0[1]); w.y = cvt_pk_bf16(v0[2], v0[3]); w.z = cvt_pk_bf16(v1[0], v1[1]); w.w = cvt_pk_bf16(v1[2], v1[3]);
                        *(u32x4*)(hb + o) = w;
                        if (W8) { typedef unsigned u32x2_t __attribute__((ext_vector_type(2))); u32x2_t q; q.x = pk4_fp8(v0[0] * 4.f, v0[1] * 4.f, v0[2] * 4.f, v0[3] * 4.f); q.y = pk4_fp8(v1[0] * 4.f, v1[1] * 4.f, v1[2] * 4.f, v1[3] * 4.f); *(u32x2_t*)(h8 + o) = q; } }
                    ss += __shfl_xor(ss, 16); ss += __shfl_xor(ss, 32);
                    if (fq == 0) ssq[(size_t)row * 16 + u.pn * 4 + wc] = ss; }
            }
    }
};
__device__ __forceinline__ float dpp_ror1(float x) { return __builtin_bit_cast(float, __builtin_amdgcn_mov_dpp(__builtin_bit_cast(int, x), 0x121, 0xf, 0xf, true)); }
__device__ __forceinline__ float dpp_ror2(float x) { return __builtin_bit_cast(float, __builtin_amdgcn_mov_dpp(__builtin_bit_cast(int, x), 0x122, 0xf, 0xf, true)); }
template <bool F8> struct EpiConv {
    static constexpr bool PERM = true, AFTER_DRAIN = false;
    bf16_t* ACT; const float* cw; const float* ssq; float* FB; float* HB; PG8_LAS float* halo;
    mutable int last_pm; PG8_LAS f32x4* rcache;
    PG8_LAS float* wbuf;
    static __device__ __forceinline__ f32x4 shr1(const f32x4 old, const f32x4 v) { f32x4 r;
#pragma unroll
        for (int e = 0; e < 4; ++e) { const float ov = old[e], vv = v[e];
            r[e] = __builtin_bit_cast(float, __builtin_amdgcn_update_dpp(__builtin_bit_cast(int, ov), __builtin_bit_cast(int, vv), 0x111, 0xf, 0xf, false)); }
        return r; }
    __device__ __forceinline__ void operator()(const f32x4 (&acc_in)[2][2][4][2], const Unit& u, int wr, int wc, int fr_, int fq_) const {
        int fr = fr_, fq = fq_; asm volatile("" : "+v"(fr), "+v"(fq));
        const int tok0 = u.pm * BM + wr * 64 + 4 * fr, lc = wc * 32 + 8 * fq;
        float rs[2][4];
        PG8_LAS f32x4* rc = rcache + 2 * ((wr * 4 + wc) * 64 + fq * 16 + fr);
        if (u.pm != last_pm) { rows_rstd(ssq, tok0, fq, rs, 1); last_pm = u.pm; rc[0] = (f32x4){rs[0][0], rs[0][1], rs[0][2], rs[0][3]}; rc[1] = (f32x4){rs[1][0], rs[1][1], rs[1][2], rs[1][3]}; }
        else { const f32x4 a_ = rc[0], b_ = rc[1]; rs[0][0] = a_[0]; rs[0][1] = a_[1]; rs[0][2] = a_[2]; rs[0][3] = a_[3]; rs[1][0] = b_[0]; rs[1][1] = b_[1]; rs[1][2] = b_[2]; rs[1][3] = b_[3]; }
#pragma unroll
        for (int ai = 0; ai < 2; ++ai)
#pragma unroll
            for (int m = 0; m < 4; ++m) rs[ai][m] *= (1.0f / 1024.0f);
        { const int t = (wr * 4 + wc) * 64 + fq * 16 + fr;
          if (t < 192) { const int tap = t >> 6, c4 = (t & 63) * 4; *(PG8_LAS f32x4*)(wbuf + tap * 256 + c4) = *(const f32x4*)(cw + tap * 5632 + (c4 >> 7) * 2816 + u.pn * HALF + (c4 & 127)); } }
#pragma unroll
        for (int ai = 0; ai < 2; ++ai) { const int b = 2 * ai + wr;
            if (fr == 15) {
#pragma unroll
                for (int bj = 0; bj < 2; ++bj)
#pragma unroll
                    for (int n = 0; n < 2; ++n) { const float k8 = bj ? 8.0f : 1.0f; const f32x4 v2 = acc_in[ai][bj][2][n] * (rs[ai][2] * k8), v3 = acc_in[ai][bj][3][n] * (rs[ai][3] * k8);
                        *(PG8_LAS f32x4*)(halo + (b * 2 + 0) * 256 + bj * HALF + lc + 4 * n) = v2; *(PG8_LAS f32x4*)(halo + (b * 2 + 1) * 256 + bj * HALF + lc + 4 * n) = v3;
                        if (b == 3) { *(f32x4*)(HB + ((size_t)u.pm * 2 + 0) * 5632 + u.pn * BM + bj * HALF + lc + 4 * n) = v2; *(f32x4*)(HB + ((size_t)u.pm * 2 + 1) * 5632 + u.pn * BM + bj * HALF + lc + 4 * n) = v3; } } }
            if (b == 0 && fr == 0) {
#pragma unroll
                for (int bj = 0; bj < 2; ++bj)
#pragma unroll
                    for (int n = 0; n < 2; ++n) { const float k8 = bj ? 8.0f : 1.0f;
                        *(f32x4*)(FB + ((size_t)u.pm * 2 + 0) * 5632 + u.pn * BM + bj * HALF + lc + 4 * n) = acc_in[0][bj][0][n] * (rs[0][0] * k8);
                        *(f32x4*)(FB + ((size_t)u.pm * 2 + 1) * 5632 + u.pn * BM + bj * HALF + lc + 4 * n) = acc_in[0][bj][1][n] * (rs[0][1] * k8); } } }
        asm volatile("s_waitcnt lgkmcnt(0)\n\ts_barrier" ::: "memory");
#pragma unroll
        for (int ai = 0; ai < 2; ++ai) { const int b = 2 * ai + wr;
#pragma unroll
            for (int n = 0; n < 2; ++n) {
                __builtin_amdgcn_sched_barrier(0);
                const int ch = u.pn * HALF + lc + 4 * n;
                f32x4 y[2][4];
#pragma unroll
                for (int bj = 0; bj < 2; ++bj) {
                    f32x4 w0, w1, w2, p3, p2;
                    w0 = *(const PG8_LAS f32x4*)(wbuf + 0 * 256 + bj * HALF + lc + 4 * n); w1 = *(const PG8_LAS f32x4*)(wbuf + 1 * 256 + bj * HALF + lc + 4 * n); w2 = *(const PG8_LAS f32x4*)(wbuf + 2 * 256 + bj * HALF + lc + 4 * n);
                    if (b > 0) { p3 = *(const PG8_LAS f32x4*)(halo + ((b - 1) * 2 + 1) * 256 + bj * HALF + lc + 4 * n); p2 = *(const PG8_LAS f32x4*)(halo + ((b - 1) * 2 + 0) * 256 + bj * HALF + lc + 4 * n); }
                    else { p3 = (f32x4){0.f, 0.f, 0.f, 0.f}; p2 = p3; }
                    const float k8 = bj ? 8.0f : 1.0f;
                    const f32x4 a0 = acc_in[ai][bj][0][n] * (rs[ai][0] * k8), a1 = acc_in[ai][bj][1][n] * (rs[ai][1] * k8), a2 = acc_in[ai][bj][2][n] * (rs[ai][2] * k8), a3 = acc_in[ai][bj][3][n] * (rs[ai][3] * k8);
                    const f32x4 s3 = shr1(p3, a3), s2 = shr1(p2, a2);
                    y[bj][0] = w2 * a0 + w1 * s3 + w0 * s2; y[bj][1] = w2 * a1 + w1 * a0 + w0 * s3; y[bj][2] = w2 * a2 + w1 * a1 + w0 * a0; y[bj][3] = w2 * a3 + w1 * a2 + w0 * a1;
                }
#pragma unroll
                for (int m = 0; m < 4; ++m) { float o[4];
#pragma unroll
                    for (int e = 0; e < 4; ++e) { const float yg = y[0][m][e]; o[e] = yg * __builtin_amdgcn_rcpf(1.0f + __expf(-yg)) * y[1][m][e]; }
                    *(unsigned*)((unsigned char*)ACT + (size_t)(tok0 + ai * HALF + m) * 2816 + ch) = pk4_fp8(o[0], o[1], o[2], o[3]); }
                asm volatile("" ::: "memory");
            }
        }
    }
};
}

__device__ __forceinline__ void tp_item(const float* W, int ldw, int k0, int srccol, float colscale, const float* gain, bf16* WT, int ldk, int drow0, LAS float* scr, int lane, bool f8 = false) {
    const float cm = (srccol >= 0) ? colscale : 0.f;
    const float* wp = W + (size_t)(k0 + (lane >> 5)) * ldw + (srccol >= 0 ? srccol : 0);
    float v[32];
#pragma unroll
    for (int i = 0; i < 32; ++i) v[i] = wp[(size_t)(2 * i) * ldw];
    if (gain) { const float* gp = gain + k0 + (lane >> 5); float gq[32];
#pragma unroll
        for (int i = 0; i < 32; ++i) gq[i] = gp[2 * i];
#pragma unroll
        for (int i = 0; i < 32; ++i) v[i] *= gq[i]; }
#pragma unroll
    for (int i = 0; i < 32; ++i) scr[(2 * i + (lane >> 5)) * 33 + (lane & 31)] = v[i] * cm;
    LDS_WAIT(); asm volatile("" ::: "memory");
    const int c = lane & 7;
#pragma unroll
    for (int j = 0; j < 4; ++j) { const int n = (lane >> 3) + 8 * j; const LAS float* s = scr + (8 * c) * 33 + n;
        if (f8) { typedef unsigned u32x2_t __attribute__((ext_vector_type(2))); u32x2_t q; q.x = pg8::pk4_fp8(s[0 * 33] * 256.f, s[1 * 33] * 256.f, s[2 * 33] * 256.f, s[3 * 33] * 256.f); q.y = pg8::pk4_fp8(s[4 * 33] * 256.f, s[5 * 33] * 256.f, s[6 * 33] * 256.f, s[7 * 33] * 256.f);
            *(u32x2_t*)((unsigned char*)WT + (size_t)(drow0 + n) * ldk + k0 + 8 * c) = q; continue; }
        v4u o; o.x = pk2(s[0 * 33], s[1 * 33]); o.y = pk2(s[2 * 33], s[3 * 33]); o.z = pk2(s[4 * 33], s[5 * 33]); o.w = pk2(s[6 * 33], s[7 * 33]);
        *(v4u*)(WT + (size_t)(drow0 + n) * ldk + k0 + 8 * c) = o; }
    LDS_WAIT(); asm volatile("" ::: "memory");
}
__device__ __forceinline__ int win_srccol_a(int n) {
    if (n < 512) return n;
    if (n < 640) return 512 + (n - 512);
    if (n < 664) return 1280 + (n - 640);
    if (n < 672) return 3352 + (n - 664);
    if (n < 768) return -1;
    if (n < 1792) return 1304 + (n - 768);
    return 2840 + (n - 1792);
}
__device__ __forceinline__ int win_srccol_b(int n) {
    if (n < 128) return 640 + n;
    if (n < 256) return 896 + (n - 128);
    if (n < 384) return 1152 + (n - 256);
    if (n < 512) return 768 + (n - 384);
    if (n < 640) return 1024 + (n - 512);
    if (n < 768) return -1;
    return 2328 + (n - 768);
}

namespace nsa {
typedef short bf16x8 __attribute__((ext_vector_type(8)));
typedef float f32x16 __attribute__((ext_vector_type(16)));
typedef short s16x4 __attribute__((ext_vector_type(4)));
typedef float f32x2_t __attribute__((ext_vector_type(2))); typedef __bf16 bf16x2_t __attribute__((ext_vector_type(2)));
__device__ __forceinline__ unsigned cvtpk(float lo, float hi) { f32x2_t v = {lo, hi}; bf16x2_t b = __builtin_convertvector(v, bf16x2_t); return __builtin_bit_cast(unsigned, b); }
__device__ __forceinline__ int swz8(int r) { return (((r >> 1) & 1) << 2) | (((r >> 2) & 1) << 1) | ((r >> 3) & 1); }
__device__ __forceinline__ int crow(int r, int hi) { return (r & 3) + 8 * (r >> 2) + 4 * hi; }
__device__ __forceinline__ s16x4 vtr(const LAS unsigned char* p) { typedef short v4i16_t __attribute__((ext_vector_type(4))); return __builtin_bit_cast(s16x4, __builtin_amdgcn_ds_read_tr16_b64_v4i16((LAS v4i16_t*)p)); }
#define NSA_BAR() asm volatile("s_waitcnt lgkmcnt(0)\n\ts_barrier" ::: "memory")
__device__ __forceinline__ void glds16(const void* gsrc, unsigned lds_dst) { unsigned keep;
    asm volatile("s_mov_b32 %0, m0\n\ts_mov_b32 m0, %2\n\ts_nop 0\n\tglobal_load_lds_dwordx4 %1, off\n\ts_mov_b32 m0, %0" : "=&s"(keep) : "v"(gsrc), "s"(lds_dst) : "memory"); }
__device__ __forceinline__ float max2f(float a, float b) { float r; asm("v_max_f32_e32 %0, %1, %2" : "=v"(r) : "v"(a), "v"(b)); return r; }
__device__ __forceinline__ float max3f(float a, float b, float c) { float r; asm("v_max3_f32 %0, %1, %2, %3" : "=v"(r) : "v"(a), "v"(b), "v"(c)); return r; }
#define EXP2(x) __builtin_amdgcn_exp2f(x)

constexpr int IMP_P = 33, L_IMP = 0, L_SELM = 8448, L_WSC = 8704, L_K = 11264, L_V = L_K + 32768, L_OST = L_V + 32768, OST_PITCH = 1040, L_END = L_OST + 64 * OST_PITCH;
static_assert(L_END <= 158 * 1024, "nsa lds");

struct Lane {
    int tid, lane, w, r32, hi, g, th;
    int kbase; int ko[4];
    int vbase, xv;
    int soff;
    int goff;
    int goff8, k8a, k8b;
};
__device__ __forceinline__ void lane_init(Lane& L, int tid) {
    L.tid = tid; L.lane = tid & 63; L.w = __builtin_amdgcn_readfirstlane(tid >> 6); L.r32 = L.lane & 31; L.hi = L.lane >> 5; L.g = L.w >> 1; L.th = L.w & 1;
    const int sw = swz8(L.r32); L.kbase = L.r32 * 128;
#pragma unroll
    for (int d0 = 0; d0 < 4; ++d0) L.ko[d0] = ((2 * d0 + L.hi) ^ sw) << 4;
    const int kq = (L.lane & 15) >> 2, swl = (((kq >> 1) & 1) << 2) | (L.hi << 1), cl = 2 * ((L.lane >> 4) & 1) + ((L.lane & 3) >> 1);
    L.xv = cl ^ swl; L.vbase = (4 * L.hi + kq) * 128 + 8 * (L.lane & 1);
    const int row = tid >> 3, c = tid & 7; L.soff = row * 128 + ((c ^ swz8(row)) << 4); L.goff = row * 128 + ((c ^ swz8(row)) << 4);
    { const int key = 16 * (L.w & 3) + (L.lane >> 2), sw = (L.lane >> 4) & 3; L.goff8 = key * 64 + (((L.lane & 3) ^ sw) << 4);
      const int sw2 = (L.r32 >> 2) & 3; L.k8a = L.r32 * 64 + (((2 * L.hi) ^ sw2) << 4); L.k8b = L.r32 * 64 + (((2 * L.hi + 1) ^ sw2) << 4); }
}
__device__ __forceinline__ void tile_scores(const LAS unsigned char* kt, const Lane& L, const bf16x8 (&qf)[4], const f32x16& cinit, f32x16& p0, f32x16& p1) {
#pragma unroll
    for (int d0 = 0; d0 < 4; ++d0) {
        const bf16x8 a0 = *(const LAS bf16x8*)(kt + L.kbase + L.ko[d0]);
        const bf16x8 a1 = *(const LAS bf16x8*)(kt + L.kbase + 32 * 128 + L.ko[d0]);
        if (d0 == 0) { p0 = __builtin_amdgcn_mfma_f32_32x32x16_bf16(a0, qf[0], cinit, 0, 0, 0); p1 = __builtin_amdgcn_mfma_f32_32x32x16_bf16(a1, qf[0], cinit, 0, 0, 0); }
        else { p0 = __builtin_amdgcn_mfma_f32_32x32x16_bf16(a0, qf[d0], p0, 0, 0, 0); p1 = __builtin_amdgcn_mfma_f32_32x32x16_bf16(a1, qf[d0], p1, 0, 0, 0); }
    }
    asm volatile("s_nop 15\n\ts_nop 7" : "+v"(p0), "+v"(p1));
}
typedef int i32x8 __attribute__((ext_vector_type(8))); typedef int i32x4 __attribute__((ext_vector_type(4)));
__device__ __forceinline__ f32x16 mfma8(const i32x8& a, const i32x8& b, const f32x16& c, int sa, int sb) { f32x16 d;
    asm("v_mfma_scale_f32_32x32x64_f8f6f4 %0, %1, %2, %3, %4, %5 op_sel_hi:[0,0,0]" : "=&v"(d) : "v"(a), "v"(b), "v"(c), "v"(sa), "v"(sb)); return d; }
__device__ __forceinline__ void tile_scores8(const LAS unsigned char* kt, const Lane& L, const i32x8& q8, const f32x16& cinit, f32x16& p0, f32x16& p1, int sa, int sb) {
    const i32x4 a0 = *(const LAS i32x4*)(kt + L.k8a), a1 = *(const LAS i32x4*)(kt + L.k8b), b0 = *(const LAS i32x4*)(kt + 2048 + L.k8a), b1 = *(const LAS i32x4*)(kt + 2048 + L.k8b);
    const i32x8 ka = __builtin_shufflevector(a0, a1, 0, 1, 2, 3, 4, 5, 6, 7), kb = __builtin_shufflevector(b0, b1, 0, 1, 2, 3, 4, 5, 6, 7);
    p0 = mfma8(ka, q8, cinit, sa, sb); p1 = mfma8(kb, q8, cinit, sa, sb);
    asm volatile("s_nop 15\n\ts_nop 7" : "+v"(p0), "+v"(p1));
}
__device__ __forceinline__ void mfma8acc(f32x16& acc, const i32x8& a, const i32x8& b, int sa, int sb) {
    asm("v_mfma_scale_f32_32x32x64_f8f6f4 %0, %1, %2, %0, %3, %4 op_sel_hi:[0,0,0]" : "+v"(acc) : "v"(a), "v"(b), "v"(sa), "v"(sb)); }
__device__ __forceinline__ int cvt4f8(float a, float b, float c, float d) { int p = __builtin_amdgcn_cvt_pk_fp8_f32(a, b, 0, false); return __builtin_amdgcn_cvt_pk_fp8_f32(c, d, p, true); }
__device__ __forceinline__ void tile_pv8(const LAS unsigned char* vt, const Lane& L, const f32x16& p0, const f32x16& p1, f32x16 (&o)[2], unsigned pmask, int sp, int sv) {
    i32x8 pa;
#pragma unroll
    for (int i = 0; i < 4; ++i) { pa[i] = cvt4f8(p0[4 * i], p0[4 * i + 1], p0[4 * i + 2], p0[4 * i + 3]) & (int)pmask; pa[4 + i] = cvt4f8(p1[4 * i], p1[4 * i + 1], p1[4 * i + 2], p1[4 * i + 3]) & (int)pmask; }
    const i32x4 a0 = *(const LAS i32x4*)(vt + L.k8a), a1 = *(const LAS i32x4*)(vt + L.k8b), b0 = *(const LAS i32x4*)(vt + 2048 + L.k8a), b1 = *(const LAS i32x4*)(vt + 2048 + L.k8b);
    const i32x8 v0 = __builtin_shufflevector(a0, a1, 0, 1, 2, 3, 4, 5, 6, 7), v1 = __builtin_shufflevector(b0, b1, 0, 1, 2, 3, 4, 5, 6, 7);
    mfma8acc(o[0], pa, v0, sp, sv); mfma8acc(o[1], pa, v1, sp, sv);
}
__device__ __forceinline__ void tile_pv(const LAS unsigned char* vt, const Lane& L, const f32x16& p0, const f32x16& p1, f32x16 (&o)[2], unsigned pmask = 0xffffffffu) {
#pragma unroll
    for (int kb = 0; kb < 2; ++kb)
#pragma unroll
        for (int s = 0; s < 2; ++s) {
            const f32x16& p = kb ? p1 : p0;
            typedef unsigned u32x4_t __attribute__((ext_vector_type(4)));
            u32x4_t pw; pw[0] = cvtpk(p[8 * s + 0], p[8 * s + 1]); pw[1] = cvtpk(p[8 * s + 2], p[8 * s + 3]); pw[2] = cvtpk(p[8 * s + 4], p[8 * s + 5]); pw[3] = cvtpk(p[8 * s + 6], p[8 * s + 7]);
            pw[0] &= pmask; pw[1] &= pmask; pw[2] &= pmask; pw[3] &= pmask;
            const bf16x8 pa = __builtin_bit_cast(bf16x8, pw);
#pragma unroll
            for (int dblk = 0; dblk < 2; ++dblk) {
                const LAS unsigned char* vb = vt + L.vbase + (kb * 32 + 16 * s) * 128;
                const s16x4 lo = vtr(vb + (((L.xv ^ (dblk << 2)) ^ 0) << 4));
                const s16x4 hi4 = vtr(vb + 8 * 128 + (((L.xv ^ (dblk << 2)) ^ 1) << 4));
                const bf16x8 vf = (bf16x8){lo[0], lo[1], lo[2], lo[3], hi4[0], hi4[1], hi4[2], hi4[3]};
                o[dblk] = __builtin_amdgcn_mfma_f32_32x32x16_bf16(pa, vf, o[dblk], 0, 0, 0);
            }
        }
}
__device__ __forceinline__ float rowmax32(const f32x16& p0, const f32x16& p1) {
    float a = max2f(p0[0], p1[0]), b = max2f(p0[1], p1[1]);
#pragma unroll
    for (int r = 2; r < 16; r += 2) { a = max3f(a, p0[r], p1[r]); b = max3f(b, p0[r + 1], p1[r + 1]); }
    a = max2f(a, b);
    return max2f(a, __shfl_xor(a, 32));
}
__device__ __forceinline__ void scale_rows(LAS float* wsc, const Lane& L, float sc, f32x16 (&o)[2]) {
    if (L.hi == 0) wsc[L.r32] = sc;
    asm volatile("s_waitcnt lgkmcnt(0)" ::: "memory");
#pragma unroll
    for (int i = 0; i < 4; ++i) { const f32x4 a = *(const LAS f32x4*)(wsc + 8 * i + 4 * L.hi);
#pragma unroll
        for (int d = 0; d < 2; ++d) { o[d][4 * i + 0] *= a[0]; o[d][4 * i + 1] *= a[1]; o[d][4 * i + 2] *= a[2]; o[d][4 * i + 3] *= a[3]; } }
    asm volatile("s_waitcnt lgkmcnt(0)" ::: "memory");
}
template <bool ADD> __device__ __forceinline__ void ost_add(LAS bf16* ostw, const Lane& L, const f32x16 (&o)[2]) {
#pragma unroll
    for (int d = 0; d < 2; ++d)
#pragma unroll
        for (int r = 0; r < 16; ++r) { LAS bf16* p = ostw + crow(r, L.hi) * (OST_PITCH / 2) + d * 32 + L.r32; float v = o[d][r]; if (ADD) v += bf2f(*p); *p = (bf16)f2bf(v); }
}
template <int MODE> __device__ __forceinline__ void branch(const unsigned char* Kg8, const unsigned char* Vg8, int j0, int j1, int qb, int tq, unsigned selm, const i32x8& q8, LAS bf16* ostw, float gate,
                                                           LAS unsigned char* lds, const Lane& L) {
    float m = 0.f, l = 0.f; f32x16 o[2], negm;
#pragma unroll
    for (int r = 0; r < 16; ++r) { o[0][r] = 0.f; o[1][r] = 0.f; negm[r] = 0.f; }
    LAS float* wsc = (LAS float*)(lds + L_WSC) + L.w * 64;
    const int NT = j1 - j0 + 1;
    const unsigned char* kp = Kg8 + (size_t)j0 * 4096 + L.goff8; const unsigned char* vp = Vg8 + (size_t)j0 * 4096 + L.goff8;
    int sa8 = 0x7d7d7d7d, sb8 = 0x7a7a7a7a, sp8 = 0x7f7f7f7f; asm volatile("" : "+v"(sa8), "+v"(sb8), "+v"(sp8));
    const unsigned kdst0 = (unsigned)(size_t)(lds + L_K + (L.w & 3) * 1024), vdst0 = (unsigned)(size_t)(lds + L_V + (L.w & 3) * 1024);
#define NSA_DMA(t) do { if (L.w < 4) glds16(kp + (size_t)(t) * 4096, (unsigned)__builtin_amdgcn_readfirstlane((int)(kdst0 + ((t) & 7) * 4096))); \
                        else glds16(vp + (size_t)(t) * 4096, (unsigned)__builtin_amdgcn_readfirstlane((int)(vdst0 + ((t) & 7) * 4096))); } while (0)
    const int NP = (NT + 1) >> 1;
    NSA_BAR();
    NSA_DMA(0); if (NT > 1) NSA_DMA(1); if (NT > 2) NSA_DMA(2); if (NT > 3) NSA_DMA(3);
    for (int ip = 0; ip < NP; ++ip) {
        const int ta = 2 * ip, ja = j0 + ta, jb2 = ja + 1; const bool hasb = ta + 1 < NT;
        if ((ip & 1) == 0) {
            asm volatile("s_waitcnt vmcnt(0)" ::: "memory");
            NSA_BAR();
            if (ta + 4 < NT) NSA_DMA(ta + 4);
            if (ta + 5 < NT) NSA_DMA(ta + 5);
            if (ta + 6 < NT) NSA_DMA(ta + 6);
            if (ta + 7 < NT) NSA_DMA(ta + 7);
        }
        const LAS unsigned char* kta = lds + L_K + (ta & 7) * 4096; const LAS unsigned char* vta = lds + L_V + (ta & 7) * 4096;
        const bool sela = (MODE == 1) ? (((selm >> ja) & 1u) != 0u) : true, selb = hasb && ((MODE == 1) ? (((selm >> jb2) & 1u) != 0u) : true);
        f32x16 pa0, pa1, pb0, pb1;
        tile_scores8(kta, L, q8, negm, pa0, pa1, sa8, sb8);
        if (hasb) tile_scores8(lds + L_K + ((ta + 1) & 7) * 4096, L, q8, negm, pb0, pb1, sa8, sb8);
        else {
#pragma unroll
            for (int r = 0; r < 16; ++r) { pb0[r] = -INFINITY; pb1[r] = -INFINITY; } }
#define NSA_MASKS(P0, P1, J) do { \
        if ((J) == qb) {                                             \
            int tqv = tq - 4 * L.hi; asm volatile("" : "+v"(tqv)); \
            _Pragma("unroll") for (int r = 0; r < 16; ++r) { const int kl = crow(r, 0); P0[r] = (kl > tqv) ? -INFINITY : P0[r]; P1[r] = (kl + 32 > tqv) ? -INFINITY : P1[r]; } } \
        if (MODE == 2 && (J) == qb - 8) {                            \
            int tqv = tq - 4 * L.hi; asm volatile("" : "+v"(tqv)); \
            _Pragma("unroll") for (int r = 0; r < 16; ++r) { const int kl = crow(r, 0); P0[r] = (kl <= tqv) ? -INFINITY : P0[r]; P1[r] = (kl + 32 <= tqv) ? -INFINITY : P1[r]; } } } while (0)
        NSA_MASKS(pa0, pa1, ja);
        if (hasb) NSA_MASKS(pb0, pb1, jb2);
#undef NSA_MASKS
        float rma = rowmax32(pa0, pa1), rmb = rowmax32(pb0, pb1);
        if (MODE == 1) { rma = sela ? rma : -INFINITY; rmb = selb ? rmb : -INFINITY; }
        const float rm = max2f(rma, rmb);
        const bool up = rm > 6.0f, dn = (rm < -64.0f) && (rm > -INFINITY) && (l == 0.f);
        if (__any(up || dn)) {
            const float dl = (up || dn) ? rm : 0.f;
            const float alpha = (l == 0.f) ? 1.0f : EXP2(-dl);
#pragma unroll
            for (int r = 0; r < 16; ++r) { pa0[r] -= dl; pa1[r] -= dl; pb0[r] -= dl; pb1[r] -= dl; }
            l *= alpha; m += dl; scale_rows(wsc, L, alpha, o);
#pragma unroll
            for (int r = 0; r < 16; ++r) negm[r] = -m;
        }
        float suma = 0.f, sumb = 0.f;
#pragma unroll
        for (int r = 0; r < 16; ++r) { pa0[r] = EXP2(pa0[r]); pa1[r] = EXP2(pa1[r]); suma += pa0[r] + pa1[r]; }
        tile_pv8(vta, L, pa0, pa1, o, (MODE == 1 && !sela) ? 0u : 0xffffffffu, sp8, sa8);
        if (hasb) {
#pragma unroll
            for (int r = 0; r < 16; ++r) { pb0[r] = EXP2(pb0[r]); pb1[r] = EXP2(pb1[r]); sumb += pb0[r] + pb1[r]; }
            tile_pv8(lds + L_V + ((ta + 1) & 7) * 4096, L, pb0, pb1, o, (MODE == 1 && !selb) ? 0u : 0xffffffffu, sp8, sa8);
        }
        l += ((MODE == 1 && !sela) ? 0.f : suma) + ((MODE == 1 && !selb) ? 0.f : sumb);
    }
#undef NSA_DMA
    asm volatile("s_nop 15\n\ts_nop 7" : "+v"(o[0]), "+v"(o[1]));
    l += __shfl_xor(l, 32);
    const float sc = (l > 0.f) ? gate / l : 0.f;
    scale_rows(wsc, L, sc, o);
    ost_add<true>(ostw, L, o);
}

__device__ __forceinline__ void phase(const bf16* Qb, const bf16* KVb, const bf16* KC, const bf16* SMb, const bf16* OG, const bf16* Zb, bf16* MIX, LAS unsigned char* lds, int blk, int G, int tid_in) {
    Lane L; lane_init(L, tid_in);
    const int tid = L.tid, lane = L.lane, w = L.w, r32 = L.r32, hi = L.hi;
    LAS float* IMP = (LAS float*)(lds + L_IMP); LAS unsigned* SELM = (LAS unsigned*)(lds + L_SELM); LAS float* wsc = (LAS float*)(lds + L_WSC) + w * 64;
    for (int u = blk; u < 1024; u += G) {
        const int b = (u & 255) >> 3, s8 = u & 7, ui = u >> 8;
        const unsigned grp = (s8 == 0) ? 0x1f1e0501u : (s8 == 1) ? 0x1d1c0602u : (s8 == 2) ? 0x1b1a0703u : (s8 == 3) ? 0x19180904u : (s8 == 4) ? 0x17161500u : (s8 == 5) ? 0x14130b08u : (s8 == 6) ? 0x12110d0au : 0x100f0e0cu;
        const int qb = (int)((grp >> (8 * ui)) & 31u);
        const int tok0 = b * SEQ + 64 * qb, tq = 32 * L.th + r32, t = 64 * qb + tq;
        for (int hkv = 0; hkv < 2; ++hkv) {
            const int head = hkv * 4 + L.g;
            bf16x8 qf[4];
            { const bf16* qrow = Qb + (size_t)(tok0 + tq) * 512 + head * 64;
#pragma unroll
              for (int d0 = 0; d0 < 4; ++d0) qf[d0] = *(const bf16x8*)(qrow + 16 * d0 + 8 * hi); }
            const bf16* gp = SMb + (size_t)(tok0 + tq) * 32 + head * 3;
            const float gate0 = sigmf(bf2f(gp[0])), gate1 = sigmf(bf2f(gp[1])), gate2 = sigmf(bf2f(gp[2]));
            LAS bf16* ostw = (LAS bf16*)(lds + L_OST) + (32 * L.th) * (OST_PITCH / 2) + head * 64;
            v4u ckv[2][2];
            { const bf16* kcb = KC + ((size_t)((0 * 32 + b) * 2 + hkv) * 128) * 64; const bf16* vcb = KC + ((size_t)((1 * 32 + b) * 2 + hkv) * 128) * 64;
#pragma unroll
              for (int i = 0; i < 2; ++i) { const int e = tid + 512 * i; ckv[i][0] = *(const v4u*)(kcb + (size_t)e * 8); ckv[i][1] = *(const v4u*)(vcb + (size_t)e * 8); } }
            __builtin_amdgcn_sched_barrier(0);
            NSA_BAR();
#pragma unroll
            for (int i = 0; i < 2; ++i) { const int e = tid + 512 * i, row = e >> 3, c = e & 7, off = row * 128 + ((c ^ swz8(row)) << 4);
                *(LAS v4u*)(lds + L_K + off) = ckv[i][0]; *(LAS v4u*)(lds + L_V + off) = ckv[i][1]; }
            NSA_BAR();
            {
                f32x16 pa0, pa1, pb0, pb1, zinit;
#pragma unroll
                for (int r = 0; r < 16; ++r) zinit[r] = 0.f;
                tile_scores(lds + L_K, L, qf, zinit, pa0, pa1); tile_scores(lds + L_K + 8192, L, qf, zinit, pb0, pb1);
                const int nmax = (t >= 31) ? ((t - 31) >> 4) : -1;
                int nmv = nmax - 4 * hi; asm volatile("" : "+v"(nmv));
#pragma unroll
                for (int r = 0; r < 16; ++r) { const int n = crow(r, 0);
                    pa0[r] = (n > nmv) ? -INFINITY : pa0[r]; pa1[r] = (n + 32 > nmv) ? -INFINITY : pa1[r]; pb0[r] = (n + 64 > nmv) ? -INFINITY : pb0[r]; pb1[r] = (n + 96 > nmv) ? -INFINITY : pb1[r]; }
                const float m = max2f(rowmax32(pa0, pa1), rowmax32(pb0, pb1)), ms = (m == -INFINITY) ? 0.f : m;
                float sum = 0.f;
#pragma unroll
                for (int r = 0; r < 16; ++r) { pa0[r] = EXP2(pa0[r] - ms); pa1[r] = EXP2(pa1[r] - ms); pb0[r] = EXP2(pb0[r] - ms); pb1[r] = EXP2(pb1[r] - ms); sum += (pa0[r] + pa1[r]) + (pb0[r] + pb1[r]); }
                sum += __shfl_xor(sum, 32);
                const float inv = (sum > 0.f) ? 1.0f / sum : 0.f;
#pragma unroll
                for (int r = 0; r < 16; ++r) { pa0[r] *= inv; pa1[r] *= inv; pb0[r] *= inv; pb1[r] *= inv; }
                { float own[16], carry[16];
#pragma unroll
                  for (int i = 0; i < 4; ++i) {
                      own[i] = (pa0[4 * i] + pa0[4 * i + 1]) + (pa0[4 * i + 2] + pa0[4 * i + 3]); carry[i] = pa0[4 * i + 3];
                      own[4 + i] = (pa1[4 * i] + pa1[4 * i + 1]) + (pa1[4 * i + 2] + pa1[4 * i + 3]); carry[4 + i] = pa1[4 * i + 3];
                      own[8 + i] = (pb0[4 * i] + pb0[4 * i + 1]) + (pb0[4 * i + 2] + pb0[4 * i + 3]); carry[8 + i] = pb0[4 * i + 3];
                      own[12 + i] = (pb1[4 * i] + pb1[4 * i + 1]) + (pb1[4 * i + 2] + pb1[4 * i + 3]); carry[12 + i] = pb1[4 * i + 3]; }
                  float recv[16];
#pragma unroll
                  for (int k = 0; k < 16; ++k) recv[k] = __shfl_xor(carry[k], 32);
                  LAS float* impw = (LAS float*)(lds + (w < 4 ? L_K + 16384 : L_V + 16384)) + (w & 3) * 1024 + r32;
#pragma unroll
                  for (int k = 0; k < 16; ++k) { const float add = hi ? recv[k] : (k > 0 ? recv[k - 1] : 0.f); impw[(2 * k + hi) * 32] = own[k] + add; } }
                f32x16 o[2];
#pragma unroll
                for (int r = 0; r < 16; ++r) { o[0][r] = 0.f; o[1][r] = 0.f; }
                tile_pv(lds + L_V, L, pa0, pa1, o); tile_pv(lds + L_V + 8192, L, pb0, pb1, o);
                scale_rows(wsc, L, gate0, o);
                ost_add<false>(ostw, L, o);
            }
            NSA_BAR();
            { const int sg = tid >> 6, tk = tid & 63, th2 = tk >> 5, q = tk & 31;
#pragma unroll
              for (int e = 0; e < 4; ++e) { float sacc = 0.f;
#pragma unroll
                  for (int g = 0; g < 4; ++g) { const int ww = 2 * g + th2; sacc += *(const LAS float*)(lds + (ww < 4 ? L_K + 16384 : L_V + 16384) + ((ww & 3) * 1024 + (4 * sg + e) * 32 + q) * 4); }
                  IMP[tk * IMP_P + 4 * sg + e] = sacc; } }
            NSA_BAR();
            if (tid < 64) {
                unsigned mask;
                if (qb <= 7) mask = (2u << qb) - 1u;
                else {
                    mask = 1u | (1u << qb) | (1u << (qb - 1));
                    unsigned key[32];
#pragma unroll
                    for (int j = 0; j < 32; ++j) { const unsigned bits = __float_as_uint(IMP[tid * IMP_P + j]); key[j] = (j >= 1 && j <= qb - 2) ? ((bits & ~31u) | (unsigned)(31 - j)) : 0u; }
                    for (int rsel = 0; rsel < 5; ++rsel) { unsigned best = 0u;
#pragma unroll
                        for (int j = 1; j < 31; ++j) best = key[j] > best ? key[j] : best;
                        if (best != 0u) { const int bj = 31 - (int)(best & 31u); mask |= 1u << bj;
#pragma unroll
                            for (int j = 1; j < 31; ++j) key[j] = (key[j] == best) ? 0u : key[j]; } }
                }
                SELM[tid] = mask;
            }
            NSA_BAR();
            const unsigned selm = SELM[tq];
            i32x8 q8;
#pragma unroll
            for (int d0 = 0; d0 < 4; ++d0) { typedef unsigned u4_t __attribute__((ext_vector_type(4))); const u4_t qq = __builtin_bit_cast(u4_t, qf[d0]);
                q8[2 * d0] = (int)pg8::pk4_fp8(bflo(qq.x) * 32.f, bfhi(qq.x) * 32.f, bflo(qq.y) * 32.f, bfhi(qq.y) * 32.f); q8[2 * d0 + 1] = (int)pg8::pk4_fp8(bflo(qq.z) * 32.f, bfhi(qq.z) * 32.f, bflo(qq.w) * 32.f, bfhi(qq.w) * 32.f); }
            { const unsigned char* ks = (const unsigned char*)KVb + 2 * KV_PIECE_BYTES + ((size_t)(b * 2 + hkv) * 2048) * 64; const unsigned char* vs = (const unsigned char*)KVb + 3 * KV_PIECE_BYTES + ((size_t)(b * 2 + hkv) * 2048) * 64;
              branch<1>(ks, vs, 0, qb, qb, tq, selm, q8, ostw, gate1, lds, L); }
            { const unsigned char* kw = (const unsigned char*)KVb + 4 * KV_PIECE_BYTES + ((size_t)(b * 2 + hkv) * 2048) * 64; const unsigned char* vw = (const unsigned char*)KVb + 5 * KV_PIECE_BYTES + ((size_t)(b * 2 + hkv) * 2048) * 64;
              branch<2>(kw, vw, qb >= 8 ? qb - 8 : 0, qb, qb, tq, 0u, q8, ostw, gate2, lds, L); }
        }
        NSA_BAR();
        { const int tk = tid >> 3, seg = tid & 7; const size_t tok = (size_t)tok0 + tk;
          const v4u* op = (const v4u*)(OG + tok * 512 + seg * 64); const v4u* zp = (const v4u*)(Zb + tok * 512 + seg * 64);
          v4u ov[8], zv[8];
#pragma unroll
          for (int i = 0; i < 8; ++i) { ov[i] = op[i]; zv[i] = zp[i]; }
          { const LAS unsigned char* src = lds + L_OST + tk * OST_PITCH + seg * 128;
            v4u v[8]; float ss = 0.f;
#pragma unroll
            for (int i = 0; i < 8; ++i) { v[i] = *(const LAS v4u*)(src + 16 * i);
                ss += bflo(v[i].x) * bflo(v[i].x) + bfhi(v[i].x) * bfhi(v[i].x) + bflo(v[i].y) * bflo(v[i].y) + bfhi(v[i].y) * bfhi(v[i].y)
                    + bflo(v[i].z) * bflo(v[i].z) + bfhi(v[i].z) * bfhi(v[i].z) + bflo(v[i].w) * bflo(v[i].w) + bfhi(v[i].w) * bfhi(v[i].w); }
            ss += __shfl_xor(ss, 1); ss += __shfl_xor(ss, 2); ss += __shfl_xor(ss, 4);
            const float rstd = 1.0f / sqrtf(ss * (1.0f / 512.0f) + EPS);
            bf16* dst = MIX + tok * 1024 + seg * 64;
#pragma unroll
            for (int i = 0; i < 8; ++i) { v4u o; o.x = pk2(bflo(v[i].x) * rstd, bfhi(v[i].x) * rstd); o.y = pk2(bflo(v[i].y) * rstd, bfhi(v[i].y) * rstd);
                o.z = pk2(bflo(v[i].z) * rstd, bfhi(v[i].z) * rstd); o.w = pk2(bflo(v[i].w) * rstd, bfhi(v[i].w) * rstd); *(v4u*)(dst + 8 * i) = o; } }
          { float ss = 0.f;
#pragma unroll
            for (int i = 0; i < 8; ++i) { const v4u a = ov[i];
                ss += bflo(a.x) * bflo(a.x) + bfhi(a.x) * bfhi(a.x) + bflo(a.y) * bflo(a.y) + bfhi(a.y) * bfhi(a.y) + bflo(a.z) * bflo(a.z) + bfhi(a.z) * bfhi(a.z) + bflo(a.w) * bflo(a.w) + bfhi(a.w) * bfhi(a.w); }
            ss += __shfl_xor(ss, 1);
            const float rstd = 1.0f / sqrtf(ss * (1.0f / 128.0f) + EPS);
            bf16* dst = MIX + tok * 1024 + 512 + seg * 64;
#pragma unroll
            for (int i = 0; i < 8; ++i) { const v4u a = ov[i], z = zv[i]; v4u o;
                o.x = pk2(bflo(a.x) * rstd * siluf(bflo(z.x)), bfhi(a.x) * rstd * siluf(bfhi(z.x))); o.y = pk2(bflo(a.y) * rstd * siluf(bflo(z.y)), bfhi(a.y) * rstd * siluf(bfhi(z.y)));
                o.z = pk2(bflo(a.z) * rstd * siluf(bflo(z.z)), bfhi(a.z) * rstd * siluf(bfhi(z.z))); o.w = pk2(bflo(a.w) * rstd * siluf(bflo(z.w)), bfhi(a.w) * rstd * siluf(bfhi(z.w)));
                *(v4u*)(dst + 8 * i) = o; } } }
    }
}
}

namespace gdn {
typedef short bf16x8 __attribute__((ext_vector_type(8)));
typedef float f32x16 __attribute__((ext_vector_type(16)));
using nsa::crow; using nsa::cvtpk;
typedef unsigned u32x2 __attribute__((ext_vector_type(2)));
#define GDN_BAR() asm volatile("s_waitcnt lgkmcnt(0)\n\ts_barrier" ::: "memory")
constexpr int IP = 272;
constexpr int AOP = 144, XTP = 144;
constexpr int L_SC = 0, L_AT = 3072, L_QI = L_AT + 64 * 64 * 4, L_KI = L_QI + 64 * IP, L_VI = L_KI + 64 * IP, L_AO = L_VI + 64 * IP, L_XT = L_AO + 64 * AOP, L_TI = L_XT + 256 * XTP, L_RT = L_TI + 2048, L_PRE_END = L_RT + 256 * 32;
static_assert(L_PRE_END <= 158 * 1024, "gdn pre lds");
constexpr int ITEM_BYTES = 73728, O_W = 0, O_UT = 16384, O_QG = 32768, O_KGT = 49152, O_ATT = 65536;

__device__ __forceinline__ void pre_phase(const bf16* Gb, const bf16* SMb, const float* convw, const float* a_log, const float* dt_bias, unsigned char* GP, float* GL,
                                          LAS unsigned char* lds, int blk, int G, int tid) {
    const int lane = tid & 63, w = __builtin_amdgcn_readfirstlane(tid >> 6), r32 = lane & 31, hi = lane >> 5;
    LAS float* SC = (LAS float*)(lds + L_SC); LAS float* AT = (LAS float*)(lds + L_AT);
    int par = 0;
    const bool deal = (G == 256); const int nit = deal ? (blk < 128 ? 15 : 17) : (NB * GH * 32 - blk + G - 1) / G;
    for (int ii = 0; ii < nit; ++ii, par ^= 1) {
        const int item = (deal && ii == 16) ? 15 * 256 + (blk - 128) : blk + ii * G;
        const int bh = item >> 5, c = item & 31, b = bh >> 2, h = bh & 3, tok0 = b * SEQ + 64 * c;
        unsigned char* out = GP + (size_t)item * ITEM_BYTES;
        GDN_BAR();
        if (w == 7) {
            const size_t tok = (size_t)tok0 + lane;
            const float bb = bf2f(SMb[tok * 32 + 24 + h]), aa = bf2f(SMb[tok * 32 + 28 + h]);
            const float g = -__expf(a_log[h]) * softplusf(aa + dt_bias[h]);
            float gc = g;
#pragma unroll
            for (int o = 1; o < 64; o <<= 1) { const float t = __shfl_up(gc, o); if (lane >= o) gc += t; }
            const float glast = __shfl(gc, 63);
            SC[lane] = gc; SC[64 + lane] = sigmf(bb); SC[128 + lane] = __expf(gc); SC[192 + lane] = __expf(glast - gc);
            if (lane == 0) GL[item] = __expf(glast);
        }
#pragma unroll
        for (int si = 0; si < 2; ++si) {
            if (si == 1 && w >= 4) break;
            const int sidx = tid + 512 * si, cg = sidx % 48, t4 = sidx / 48, which = cg >> 4, col = which * 512 + h * 128 + 8 * (cg & 15);
            f32x4 wt[4][2];
#pragma unroll
            for (int j = 0; j < 4; ++j) { wt[j][0] = *(const f32x4*)(convw + j * 1536 + col); wt[j][1] = *(const f32x4*)(convw + j * 1536 + col + 4); }
            v4u rw[7];
#pragma unroll
            for (int rr = 0; rr < 7; ++rr) { const int sq = 64 * c + 4 * t4 - 3 + rr; rw[rr] = (sq >= 0) ? *(const v4u*)(Gb + (size_t)(tok0 + 4 * t4 - 3 + rr) * 1536 + col) : (v4u){0u, 0u, 0u, 0u}; }
#pragma unroll
            for (int t = 0; t < 4; ++t) {
                float y[8];
#pragma unroll
                for (int e = 0; e < 8; ++e) y[e] = 0.f;
#pragma unroll
                for (int j = 0; j < 4; ++j) { const v4u x = rw[t + j];
                    y[0] += wt[j][0][0] * bflo(x.x); y[1] += wt[j][0][1] * bfhi(x.x); y[2] += wt[j][0][2] * bflo(x.y); y[3] += wt[j][0][3] * bfhi(x.y);
                    y[4] += wt[j][1][0] * bflo(x.z); y[5] += wt[j][1][1] * bfhi(x.z); y[6] += wt[j][1][2] * bflo(x.w); y[7] += wt[j][1][3] * bfhi(x.w); }
#pragma unroll
                for (int e = 0; e < 8; ++e) { y[e] = siluf(y[e]); }
                v4u o; o.x = pk2(y[0], y[1]); o.y = pk2(y[2], y[3]); o.z = pk2(y[4], y[5]); o.w = pk2(y[6], y[7]);
                const int tk = 4 * t4 + t;
                *(LAS v4u*)(lds + L_QI + which * (64 * IP) + tk * IP + 16 * (cg & 15)) = o;
                if (which < 2) {
                    float tt = (y[0] * y[0] + y[1] * y[1]) + (y[2] * y[2] + y[3] * y[3]) + (y[4] * y[4] + y[5] * y[5]) + (y[6] * y[6] + y[7] * y[7]);
                    tt += __builtin_bit_cast(float, __builtin_amdgcn_mov_dpp(__builtin_bit_cast(int, tt), 0x128, 0xf, 0xf, true));
                    tt += __builtin_bit_cast(float, __builtin_amdgcn_mov_dpp(__builtin_bit_cast(int, tt), 0x124, 0xf, 0xf, true));
                    tt += __builtin_bit_cast(float, __builtin_amdgcn_mov_dpp(__builtin_bit_cast(int, tt), 0x122, 0xf, 0xf, true));
                    tt += __builtin_bit_cast(float, __builtin_amdgcn_mov_dpp(__builtin_bit_cast(int, tt), 0x121, 0xf, 0xf, true));
                    if ((cg & 15) == 0) SC[384 + which * 64 + tk] = tt; }
            }
        }
        GDN_BAR();
        float pft = 0.f;
        if (ii + 1 < nit && tid < 402) {
            const int itn = (deal && ii + 1 == 16) ? 15 * 256 + (blk - 128) : blk + (ii + 1) * G;
            const int bhn = itn >> 5, cn = itn & 31, bn = bhn >> 2, hn = bhn & 3, rown = tid / 6, segn = (tid % 6) >> 1, halfn = tid & 1;
            const int sn = 64 * cn - 3 + rown;
            if (sn >= 0) pft = *(const float*)(Gb + (size_t)(bn * SEQ + sn) * 1536 + segn * 512 + hn * 128 + halfn * 64);
        }
        if (tid < 128) { const int which = tid >> 6, tk = tid & 63; SC[256 + tid] = (1.0f / sqrtf(SC[384 + which * 64 + tk] + EPS)) * (which == 0 ? 0.08838834764831845f : 1.0f); }
        GDN_BAR();
        if (w < 4) {
            const int ti = w >> 1, tj = w & 1;
            if (tj <= ti) {
                f32x16 acc;
#pragma unroll
                for (int r = 0; r < 16; ++r) acc[r] = 0.f;
#pragma unroll
                for (int ks = 0; ks < 8; ++ks) {
                    const bf16x8 a = *(const LAS bf16x8*)(lds + L_KI + (32 * tj + r32) * IP + 32 * ks + 16 * hi);
                    const bf16x8 bq = *(const LAS bf16x8*)(lds + L_KI + (32 * ti + r32) * IP + 32 * ks + 16 * hi);
                    acc = __builtin_amdgcn_mfma_f32_32x32x16_bf16(a, bq, acc, 0, 0, 0);
                }
                const int i = 32 * ti + r32; const float gi = SC[i], bi = SC[64 + i] * SC[320 + i]; int iv = i - 4 * hi; asm volatile("" : "+v"(iv));
#pragma unroll
                for (int g4 = 0; g4 < 4; ++g4) { f32x4 v;
#pragma unroll
                    for (int e = 0; e < 4; ++e) { const int j0 = 32 * tj + 8 * g4 + e, j = j0 + 4 * hi; v[e] = (j0 < iv) ? bi * SC[320 + j] * acc[4 * g4 + e] * __expf(gi - SC[j]) : 0.f; }
                    *(LAS f32x4*)(AT + i * 64 + 32 * tj + 8 * g4 + 4 * hi) = v;
                    const bool dg = (2 * tj + (g4 >> 1)) == (i >> 4);
                    u32x2 pkd; pkd.x = dg ? 0u : cvtpk(v[0], v[1]); pkd.y = dg ? 0u : cvtpk(v[2], v[3]);
                    *(LAS u32x2*)(lds + L_AO + i * AOP + 2 * (32 * tj + 8 * g4 + 4 * hi)) = pkd; }
            } else {
                const int i = r32;
#pragma unroll
                for (int g4 = 0; g4 < 4; ++g4) *(LAS u32x2*)(lds + L_AO + i * AOP + 2 * (32 + 8 * g4 + 4 * hi)) = (u32x2){0u, 0u};
            }
        } else {
            const int ti = (w - 4) >> 1, tj = (w - 4) & 1;
            f32x16 acc;
#pragma unroll
            for (int r = 0; r < 16; ++r) acc[r] = 0.f;
            if (tj <= ti) {
#pragma unroll
                for (int ks = 0; ks < 8; ++ks) {
                    const bf16x8 a = *(const LAS bf16x8*)(lds + L_KI + (32 * tj + r32) * IP + 32 * ks + 16 * hi);
                    const bf16x8 bq = *(const LAS bf16x8*)(lds + L_QI + (32 * ti + r32) * IP + 32 * ks + 16 * hi);
                    acc = __builtin_amdgcn_mfma_f32_32x32x16_bf16(a, bq, acc, 0, 0, 0);
                }
            }
            const int i = 32 * ti + r32; const float gi = SC[i], qi = SC[256 + i]; int iv = i - 4 * hi; asm volatile("" : "+v"(iv));
            bf16* att = (bf16*)(out + O_ATT);
#pragma unroll
            for (int g4 = 0; g4 < 4; ++g4) { float v[4];
#pragma unroll
                for (int e = 0; e < 4; ++e) { const int j0 = 32 * tj + 8 * g4 + e, j = j0 + 4 * hi; v[e] = (j0 <= iv) ? qi * SC[320 + j] * acc[4 * g4 + e] * __expf(gi - SC[j]) : 0.f; }
                u32x2 pkd; pkd.x = cvtpk(v[0], v[1]); pkd.y = cvtpk(v[2], v[3]);
                *(u32x2*)(att + i * 64 + 32 * tj + 8 * g4 + 4 * hi) = pkd; }
        }
        {
            bf16* qg = (bf16*)(out + O_QG); bf16* kgt = (bf16*)(out + O_KGT);
#pragma unroll
            for (int i = 0; i < 2; ++i) { const int v = tid + 512 * i, row = v >> 4, ch = v & 15; const float e = SC[128 + row] * SC[256 + row];
                const v4u a = *(const LAS v4u*)(lds + L_QI + row * IP + 16 * ch);
                v4u o; o.x = pk2(bflo(a.x) * e, bfhi(a.x) * e); o.y = pk2(bflo(a.y) * e, bfhi(a.y) * e); o.z = pk2(bflo(a.z) * e, bfhi(a.z) * e); o.w = pk2(bflo(a.w) * e, bfhi(a.w) * e);
                *(v4u*)(qg + row * 128 + 8 * ch) = o; }
            { const int dk = tid & 127, qt = tid >> 7;
#pragma unroll
              for (int q = 0; q < 2; ++q) { float v[8];
#pragma unroll
                  for (int e = 0; e < 8; ++e) { const int cc = 16 * qt + 8 * q + e; v[e] = bf2f(*(const LAS bf16*)(lds + L_KI + cc * IP + 2 * dk)) * (SC[192 + cc] * SC[320 + cc]); }
                  v4u o; o.x = pk2(v[0], v[1]); o.y = pk2(v[2], v[3]); o.z = pk2(v[4], v[5]); o.w = pk2(v[6], v[7]);
                  *(v4u*)(kgt + dk * 64 + 16 * qt + 8 * q) = o; } }
        }
        GDN_BAR();
        if (w == 7) {
            const int d = lane >> 4, c = lane & 15; float x[16];
#pragma unroll
            for (int r = 0; r < 16; ++r) { float v = (r == c) ? 1.0f : 0.0f;
#pragma unroll
                for (int q = 0; q < (r + 3) / 4; ++q) { const f32x4 a = *(const LAS f32x4*)(AT + (16 * d + r) * 64 + 16 * d + 4 * q);
#pragma unroll
                    for (int e = 0; e < 4; ++e) if (4 * q + e < r) v -= a[e] * x[4 * q + e]; }
                x[r] = v; *(LAS bf16*)(lds + L_TI + ((d * 16 + r) * 16 + c) * 2) = (bf16)f2bf(v);
                if ((r & 3) == 3) asm volatile("" ::: "memory"); }
        }
        { const int l16 = lane & 15, lq = lane >> 4;
#pragma unroll
          for (int t2 = 0; t2 < 2; ++t2)
#pragma unroll
              for (int q = 0; q < 2; ++q) *(LAS v4u*)(lds + L_XT + (16 * (2 * w + t2) + l16) * XTP + 64 * q + 16 * lq) = (v4u){0u, 0u, 0u, 0u}; }
        GDN_BAR();
        {
            typedef float f32x4_t __attribute__((ext_vector_type(4)));
            const int l16 = lane & 15, lq = lane >> 4; const bool isu = w < 4;
            const bf16x8 zero8 = (bf16x8){0, 0, 0, 0, 0, 0, 0, 0};
#pragma unroll 1
            for (int I = 0; I < 4; ++I) {
                const bf16x8 tfr = (lq < 2) ? *(const LAS bf16x8*)(lds + L_TI + ((I * 16 + l16) * 16 + 8 * lq) * 2) : zero8;
#pragma unroll
                for (int t2 = 0; t2 < 2; ++t2) {
                    const int cidx = 16 * (2 * w + t2) + l16;
                    f32x4_t acc = {0.f, 0.f, 0.f, 0.f};
                    if (I > 0) {
#pragma unroll
                        for (int ks = 0; ks < 2; ++ks) { const bf16x8 a = *(const LAS bf16x8*)(lds + L_AO + (16 * I + l16) * AOP + 64 * ks + 16 * lq);
                            const bf16x8 bq = *(const LAS bf16x8*)(lds + L_XT + cidx * XTP + 64 * ks + 16 * lq);
                            acc = __builtin_amdgcn_mfma_f32_16x16x32_bf16(a, bq, acc, 0, 0, 0); } }
                    const LAS unsigned char* rsrc = lds + (isu ? L_VI + 2 * cidx : L_KI + 2 * (cidx - 128));
                    float rr[4];
#pragma unroll
                    for (int e = 0; e < 4; ++e) { const int i = 16 * I + 4 * lq + e; const float sc = isu ? SC[64 + i] : SC[64 + i] * SC[128 + i] * SC[320 + i]; rr[e] = bf2f(*(const LAS bf16*)(rsrc + i * IP)) * sc - acc[e]; }
                    u32x2 pkd; pkd.x = cvtpk(rr[0], rr[1]); pkd.y = cvtpk(rr[2], rr[3]);
                    *(LAS u32x2*)(lds + L_RT + cidx * 32 + 8 * lq) = pkd;
                    asm volatile("s_waitcnt lgkmcnt(0)" ::: "memory");
                    const bf16x8 rfr = (lq < 2) ? *(const LAS bf16x8*)(lds + L_RT + cidx * 32 + 16 * lq) : zero8;
                    f32x4_t xa = {0.f, 0.f, 0.f, 0.f};
                    xa = __builtin_amdgcn_mfma_f32_16x16x32_bf16(tfr, rfr, xa, 0, 0, 0);
                    u32x2 xo; xo.x = cvtpk(xa[0], xa[1]); xo.y = cvtpk(xa[2], xa[3]);
                    *(LAS u32x2*)(lds + L_XT + cidx * XTP + 2 * (16 * I + 4 * lq)) = xo;
                    if (isu) *(u32x2*)((bf16*)(out + O_UT) + cidx * 64 + 16 * I + 4 * lq) = xo;
                    else { bf16* wo = (bf16*)(out + O_W) + (size_t)(16 * I + 4 * lq) * 128 + (cidx - 128);
                        wo[0] = (bf16)(xo.x & 0xffffu); wo[128] = (bf16)(xo.x >> 16); wo[256] = (bf16)(xo.y & 0xffffu); wo[384] = (bf16)(xo.y >> 16); }
                }
                asm volatile("s_waitcnt lgkmcnt(0)" ::: "memory");
            }
        }
        asm volatile("" :: "v"(pft));
    }
}

constexpr int SP = 272, VP = 144;
constexpr int L_ST = 0, L_VN = 64 * SP, L_DEC = L_VN + 64 * VP, L_RING = L_DEC + 128, SLOT = 65536;
constexpr int R_W = 0, R_QG = 16384, R_KGT = 32768, R_ATT = 49152, R_UT = 57344;
static_assert(L_RING % 16 == 0 && L_RING + 2 * SLOT <= 158 * 1024, "scan lds");
__device__ __forceinline__ void scan_phase(const unsigned char* GP, const float* GL, bf16* OG, LAS unsigned char* lds, int blk, int G, int tid) {
    const int lane = tid & 63, w = __builtin_amdgcn_readfirstlane(tid >> 6), r32 = lane & 31, hi = lane >> 5;
    const int kbk = w & 3, vb = w >> 2, cblk = w & 1, vblk = (w >> 1) & 1, role = w >> 2;
    for (int it = blk; it < NB * GH * 2; it += G) {
        const int bh = it & 127, half = it >> 7, b = bh >> 2, h = bh & 3;
        int soff[8]; unsigned doff;
        if (w < 4) { doff = (w < 2 ? R_W : R_QG) + (w & 1) * 8192;
#pragma unroll
            for (int i = 0; i < 8; ++i) { const int row = 4 * (8 * (w & 1) + i) + (lane >> 4), cp = lane & 15; soff[i] = (w < 2 ? O_W : O_QG) + row * 256 + ((cp ^ (row & 15)) << 4); } }
        else { doff = (w < 6 ? R_KGT + (w & 1) * 8192 : (w == 6 ? R_ATT : R_UT));
#pragma unroll
            for (int i = 0; i < 8; ++i) { const int row = 8 * ((w < 6 ? 8 * (w & 1) : 0) + i) + (lane >> 3), cp = lane & 7;
                soff[i] = (w < 6 ? O_KGT : (w == 6 ? O_ATT : O_UT + half * 8192)) + row * 128 + ((cp ^ nsa::swz8(row)) << 4); } }
        const unsigned ring0 = (unsigned)(size_t)(lds + L_RING) + doff;
#define SCAN_DMA(n) do { const unsigned char* gsrc_ = GP + (size_t)(bh * 32 + (n)) * ITEM_BYTES; const unsigned d_ = ring0 + ((n) & 1) * SLOT; \
        _Pragma("unroll") for (int i_ = 0; i_ < 8; ++i_) nsa::glds16(gsrc_ + soff[i_], (unsigned)__builtin_amdgcn_readfirstlane((int)(d_ + i_ * 1024))); } while (0)
        GDN_BAR();
        SCAN_DMA(0); SCAN_DMA(1);
        for (int i = tid; i < (64 * SP) / 16; i += 512) *(LAS v4u*)(lds + L_ST + 16 * i) = (v4u){0u, 0u, 0u, 0u};
        if (tid < 32) *(LAS float*)(lds + L_DEC + 4 * tid) = GL[bh * 32 + tid];
        f32x16 sacc;
#pragma unroll
        for (int r = 0; r < 16; ++r) sacc[r] = 0.f;
        asm volatile("s_waitcnt vmcnt(8)" ::: "memory");
        GDN_BAR();
        for (int n = 0; n < 32; ++n) {
            const LAS unsigned char* sl = lds + L_RING + (n & 1) * SLOT;
            f32x16 acc, acc1;
#pragma unroll
            for (int r = 0; r < 16; ++r) { acc[r] = 0.f; acc1[r] = 0.f; }
            u32x2 uq[4];
            if (role == 0) { const int urow = 32 * vblk + r32; const LAS unsigned char* ub = sl + R_UT + urow * 128 + 8 * hi; const int usw = nsa::swz8(urow);
#pragma unroll
                for (int g4 = 0; g4 < 4; ++g4) uq[g4] = *(const LAS u32x2*)(ub + (((4 * cblk + g4) ^ usw) << 4)); }
            { const int arow = 32 * cblk + r32; const LAS unsigned char* ab = sl + (role ? R_QG : R_W) + arow * 256;
#pragma unroll
              for (int ks = 0; ks < 8; ks += 2) { const bf16x8 a = *(const LAS bf16x8*)(ab + (((2 * ks + hi) ^ (arow & 15)) << 4));
                  const bf16x8 bfr = *(const LAS bf16x8*)(lds + L_ST + (32 * vblk + r32) * SP + 32 * ks + 16 * hi);
                  const bf16x8 a2 = *(const LAS bf16x8*)(ab + (((2 * ks + 2 + hi) ^ (arow & 15)) << 4));
                  const bf16x8 bfr2 = *(const LAS bf16x8*)(lds + L_ST + (32 * vblk + r32) * SP + 32 * ks + 32 + 16 * hi);
                  acc = __builtin_amdgcn_mfma_f32_32x32x16_bf16(a, bfr, acc, 0, 0, 0); acc1 = __builtin_amdgcn_mfma_f32_32x32x16_bf16(a2, bfr2, acc1, 0, 0, 0); }
#pragma unroll
              for (int r = 0; r < 16; ++r) acc[r] += acc1[r]; }
            if (role == 0) {
#pragma unroll
                for (int g4 = 0; g4 < 4; ++g4) { const u32x2 uu = uq[g4];
                    const float v0 = bflo(uu.x) - acc[4 * g4], v1 = bfhi(uu.x) - acc[4 * g4 + 1], v2 = bflo(uu.y) - acc[4 * g4 + 2], v3 = bfhi(uu.y) - acc[4 * g4 + 3];
                    u32x2 pkd; pkd.x = cvtpk(v0, v1); pkd.y = cvtpk(v2, v3);
                    *(LAS u32x2*)(lds + L_VN + (32 * vblk + r32) * VP + 2 * (32 * cblk + 8 * g4 + 4 * hi)) = pkd; }
            }
            GDN_BAR();
            if (role == 1) {
                const int arow = 32 * cblk + r32; const LAS unsigned char* ab = sl + R_ATT + arow * 128; const int asw = nsa::swz8(arow);
#pragma unroll
                for (int ks = 0; ks < 4; ++ks) { const bf16x8 a = *(const LAS bf16x8*)(ab + (((2 * ks + hi) ^ asw) << 4));
                    const bf16x8 bfr = *(const LAS bf16x8*)(lds + L_VN + (32 * vblk + r32) * VP + 32 * ks + 16 * hi);
                    acc = __builtin_amdgcn_mfma_f32_32x32x16_bf16(a, bfr, acc, 0, 0, 0); }
                bf16* orow = OG + (size_t)(b * SEQ + 64 * n + 32 * cblk) * 512 + h * 128 + half * 64 + 32 * vblk + r32;
#pragma unroll
                for (int r = 0; r < 16; ++r) orow[(size_t)crow(r, hi) * 512] = (bf16)f2bf(acc[r]);
            }
            {
              const float dec = *(const LAS float*)(lds + L_DEC + 4 * n);
              const int krow = 32 * kbk + r32; const LAS unsigned char* kb2 = sl + R_KGT + krow * 128; const int ksw = nsa::swz8(krow);
#pragma unroll
              for (int r = 0; r < 16; ++r) sacc[r] *= dec;
#pragma unroll
              for (int ks = 0; ks < 4; ++ks) { const bf16x8 a = *(const LAS bf16x8*)(kb2 + (((2 * ks + hi) ^ ksw) << 4));
                  const bf16x8 bfr = *(const LAS bf16x8*)(lds + L_VN + (32 * vb + r32) * VP + 32 * ks + 16 * hi);
                  sacc = __builtin_amdgcn_mfma_f32_32x32x16_bf16(a, bfr, sacc, 0, 0, 0); }
#pragma unroll
              for (int g4 = 0; g4 < 4; ++g4) { u32x2 pkd; pkd.x = cvtpk(sacc[4 * g4], sacc[4 * g4 + 1]); pkd.y = cvtpk(sacc[4 * g4 + 2], sacc[4 * g4 + 3]);
                  *(LAS u32x2*)(lds + L_ST + (32 * vb + r32) * SP + 2 * (32 * kbk + 8 * g4 + 4 * hi)) = pkd; } }
            asm volatile("s_waitcnt vmcnt(0)" ::: "memory");
            GDN_BAR();
            if (n + 2 < 32) SCAN_DMA(n + 2);
        }
#undef SCAN_DMA
    }
}
}

namespace cmp {
typedef short bf16x8 __attribute__((ext_vector_type(8)));
typedef float f32x16 __attribute__((ext_vector_type(16)));
struct OneUnit {
    int c;
    __device__ bool next(int i, pg8::Unit& u) const { if (i > 0 || c >= 128) return false; const int idx = c & 63; u.pm = idx >> 1; u.pn = idx & 1; return true; }
    __device__ __forceinline__ void a_ready(const pg8::Unit&) const {}
    __device__ __forceinline__ void done(const pg8::Unit&) const {}
};
constexpr int HP = 528;
__device__ __forceinline__ void post(const bf16* P, const float* b1p, const bf16* w2T, bf16* KC, LAS unsigned char* lds, int blk, int tid) {
    if (blk >= 128) return;
    const int lane = tid & 63, w = __builtin_amdgcn_readfirstlane(tid >> 6), r32 = lane & 31, hi = lane >> 5;
    const int kv = blk >> 6, bh = blk & 63;
    const bf16* Pb = P + (size_t)kv * 8192 * 512 + (size_t)bh * 128 * 512;
    LAS float* bias = (LAS float*)(lds + 128 * HP);
    asm volatile("s_waitcnt lgkmcnt(0)\n\ts_barrier" ::: "memory");
    if (tid < 256) { const float* pp = b1p + kv * 2048 + tid; float sacc = 0.f;
#pragma unroll
        for (int k = 0; k < 8; ++k) sacc += pp[k * 256];
        bias[tid] = sacc; }
    asm volatile("s_waitcnt lgkmcnt(0)\n\ts_barrier" ::: "memory");
    for (int v = tid; v < 4096; v += 512) {
        const int n = v >> 5, c8 = (v & 31) * 8; v4u o = (v4u){0u, 0u, 0u, 0u};
        if (n < 127) { const v4u a = *(const v4u*)(Pb + (size_t)n * 512 + c8), b = *(const v4u*)(Pb + (size_t)(n + 1) * 512 + 256 + c8);
            const f32x4 b0 = *(const LAS f32x4*)(bias + c8), b1 = *(const LAS f32x4*)(bias + c8 + 4);
            o.x = pk2(gelu_tanh(bflo(a.x) + bflo(b.x) + b0[0]), gelu_tanh(bfhi(a.x) + bfhi(b.x) + b0[1])); o.y = pk2(gelu_tanh(bflo(a.y) + bflo(b.y) + b0[2]), gelu_tanh(bfhi(a.y) + bfhi(b.y) + b0[3]));
            o.z = pk2(gelu_tanh(bflo(a.z) + bflo(b.z) + b1[0]), gelu_tanh(bfhi(a.z) + bfhi(b.z) + b1[1])); o.w = pk2(gelu_tanh(bflo(a.w) + bflo(b.w) + b1[2]), gelu_tanh(bfhi(a.w) + bfhi(b.w) + b1[3])); }
        *(LAS v4u*)(lds + n * HP + 2 * c8) = o;
    }
    asm volatile("s_waitcnt lgkmcnt(0)\n\ts_barrier" ::: "memory");
    const int rb = w & 3, cb = w >> 2;
    f32x16 acc;
#pragma unroll
    for (int r = 0; r < 16; ++r) acc[r] = 0.f;
    const bf16* wrow = w2T + (size_t)kv * 64 * 256 + (32 * cb + r32) * 256 + 8 * hi;
#pragma unroll
    for (int ks = 0; ks < 16; ++ks) { const bf16x8 a = *(const LAS bf16x8*)(lds + (32 * rb + r32) * HP + 32 * ks + 16 * hi); const bf16x8 bq = *(const bf16x8*)(wrow + 16 * ks);
        acc = __builtin_amdgcn_mfma_f32_32x32x16_bf16(a, bq, acc, 0, 0, 0); }
    bf16* dst = KC + ((size_t)(kv * 64 + bh) * 128 + 32 * rb) * 64 + 32 * cb + r32;
#pragma unroll
    for (int r = 0; r < 16; ++r) dst[(size_t)nsa::crow(r, hi) * 64] = (bf16)f2bf(acc[r]);
    asm volatile("s_waitcnt lgkmcnt(0)\n\ts_barrier" ::: "memory");
}
}

__device__ __forceinline__ void rms_row_to_bf16(const float* xrow, bf16* orow, unsigned char* o8row, int lane) {
    const f32x4* xr = (const f32x4*)xrow + lane;
    f32x4 v[4]; float s = 0.f;
#pragma unroll
    for (int j = 0; j < 4; ++j) { v[j] = xr[64 * j]; s += (v[j].x * v[j].x + v[j].y * v[j].y) + (v[j].z * v[j].z + v[j].w * v[j].w); }
    const float rstd = 1.0f / sqrtf(wave_sum(s) * (1.f / DM) + EPS);
    unsigned long long* o8 = (unsigned long long*)orow + lane;
#pragma unroll
    for (int j = 0; j < 4; ++j) o8[64 * j] = (unsigned long long)pk2(v[j].x * rstd, v[j].y * rstd) | ((unsigned long long)pk2(v[j].z * rstd, v[j].w * rstd) << 32);
    const float r4 = 4.0f * rstd; unsigned* q4 = (unsigned*)o8row + lane;
#pragma unroll
    for (int j = 0; j < 4; ++j) q4[64 * j] = pg8::pk4_fp8(v[j].x * r4, v[j].y * r4, v[j].z * r4, v[j].w * r4);
}
__device__ __forceinline__ void rms_rows2_to_bf16(const float* xrow0, const float* xrow1, bf16* orow0, bf16* orow1, unsigned char* p8row0, unsigned char* p8row1, int lane) {
    const f32x4* xr0 = (const f32x4*)xrow0 + lane; const f32x4* xr1 = (const f32x4*)xrow1 + lane;
    f32x4 v0[4], v1[4]; float s0 = 0.f, s1 = 0.f;
#pragma unroll
    for (int j = 0; j < 4; ++j) { v0[j] = xr0[64 * j]; v1[j] = xr1[64 * j]; }
#pragma unroll
    for (int j = 0; j < 4; ++j) { s0 += (v0[j].x * v0[j].x + v0[j].y * v0[j].y) + (v0[j].z * v0[j].z + v0[j].w * v0[j].w); s1 += (v1[j].x * v1[j].x + v1[j].y * v1[j].y) + (v1[j].z * v1[j].z + v1[j].w * v1[j].w); }
#pragma unroll
    for (int o = 1; o < 64; o <<= 1) { s0 += __shfl_xor(s0, o); s1 += __shfl_xor(s1, o); }
    const float r0 = 1.0f / sqrtf(s0 * (1.f / DM) + EPS), r1 = 1.0f / sqrtf(s1 * (1.f / DM) + EPS);
    unsigned long long* o0 = (unsigned long long*)orow0 + lane; unsigned long long* o1 = (unsigned long long*)orow1 + lane;
#pragma unroll
    for (int j = 0; j < 4; ++j) { o0[64 * j] = (unsigned long long)pk2(v0[j].x * r0, v0[j].y * r0) | ((unsigned long long)pk2(v0[j].z * r0, v0[j].w * r0) << 32);
        o1[64 * j] = (unsigned long long)pk2(v1[j].x * r1, v1[j].y * r1) | ((unsigned long long)pk2(v1[j].z * r1, v1[j].w * r1) << 32); }
    const float r40 = 4.0f * r0, r41 = 4.0f * r1; unsigned* q0 = (unsigned*)p8row0 + lane; unsigned* q1 = (unsigned*)p8row1 + lane;
#pragma unroll
    for (int j = 0; j < 4; ++j) { q0[64 * j] = pg8::pk4_fp8(v0[j].x * r40, v0[j].y * r40, v0[j].z * r40, v0[j].w * r40); q1[64 * j] = pg8::pk4_fp8(v1[j].x * r41, v1[j].y * r41, v1[j].z * r41, v1[j].w * r41); }
}
__device__ __forceinline__ void final_norm_row(const bf16* xrow, float* orow, const float* g, float rstd, int lane) {
    const unsigned long long* xr = (const unsigned long long*)xrow + lane; f32x4* o = (f32x4*)orow + lane; const f32x4* gr = (const f32x4*)g + lane;
#pragma unroll
    for (int j = 0; j < 4; ++j) { const unsigned long long v = xr[64 * j]; const unsigned lo = (unsigned)v, hi = (unsigned)(v >> 32);
        o[64 * j] = (f32x4){bflo(lo), bfhi(lo), bflo(hi), bfhi(hi)} * rstd * gr[64 * j]; }
}

__device__ __forceinline__ void ffn_seam_fixup(const float* FBp, const float* HBp, const float* cw, bf16* ACT, int gtid, int gthreads) {
    const int total = 256 * 2 * (FF / 4);
    for (int i = gtid; i < total; i += gthreads) {
        const int pm = i / (2 * (FF / 4)), rem = i % (2 * (FF / 4)), r = rem / (FF / 4), c4 = (rem % (FF / 4)) * 4;
        if ((pm & 7) == 0) continue;
        const int col = (c4 >> 7) * 256 + (c4 & 127);
        const float* cur = FBp + ((size_t)pm * 2 + r) * FF2 + col;
        const float* p1 = (r == 0) ? HBp + ((size_t)(pm - 1) * 2 + 1) * FF2 + col : FBp + ((size_t)pm * 2 + 0) * FF2 + col;
        const float* p2 = (r == 0) ? HBp + ((size_t)(pm - 1) * 2 + 0) * FF2 + col : HBp + ((size_t)(pm - 1) * 2 + 1) * FF2 + col;
        const f32x4 g0 = *(const f32x4*)cur, g1 = *(const f32x4*)p1, g2 = *(const f32x4*)p2, u0 = *(const f32x4*)(cur + 128), u1 = *(const f32x4*)(p1 + 128), u2 = *(const f32x4*)(p2 + 128);
        const f32x4 wg0 = *(const f32x4*)(cw + c4), wg1 = *(const f32x4*)(cw + FF2 + c4), wg2 = *(const f32x4*)(cw + 2 * FF2 + c4);
        const f32x4 wu0 = *(const f32x4*)(cw + FF + c4), wu1 = *(const f32x4*)(cw + FF2 + FF + c4), wu2 = *(const f32x4*)(cw + 2 * FF2 + FF + c4);
        float o[4];
#pragma unroll
        for (int e = 0; e < 4; ++e) { const float yg = wg2[e] * g0[e] + wg1[e] * g1[e] + wg0[e] * g2[e], yu = wu2[e] * u0[e] + wu1[e] * u1[e] + wu0[e] * u2[e]; o[e] = siluf(yg) * yu; }
        *(unsigned*)((unsigned char*)ACT + (size_t)(pm * 256 + r) * FF + c4) = pg8::pk4_fp8(o[0], o[1], o[2], o[3]);
    }
}

struct Args { const float* in[22]; float* out; unsigned char* ws; };

__device__ __forceinline__ const unsigned char __attribute__((address_space(4)))* karg_base() {
    const unsigned char __attribute__((address_space(4)))* p = (const unsigned char __attribute__((address_space(4)))*)__builtin_amdgcn_kernarg_segment_ptr();
    asm volatile("" : "+s"(p)); return p; }
#define KIN(i) (*(const float* const __attribute__((address_space(4)))*)(karg_base() + 8 * (i)))
#define KOUT() (*(float* const __attribute__((address_space(4)))*)(karg_base() + 176))
#define KWS() (*(unsigned char* const __attribute__((address_space(4)))*)(karg_base() + 184))
#define LANE_ID() ((int)__builtin_amdgcn_mbcnt_hi(~0u, __builtin_amdgcn_mbcnt_lo(~0u, 0u)))
#define GRID_BAR() xcd_barrier(bar, wv == 0 && LANE_ID() == 0)
#define PHASE_IDS() int tid = wv * 64 + LANE_ID(); asm volatile("" : "+v"(tid)); const int lane = tid & 63, wave = wv, gw = blk * NWAVES + wave, NGW = G * NWAVES; (void)lane; (void)gw; (void)NGW
template <int l> __device__ __forceinline__ void layer_body(unsigned char* ws, LAS unsigned char* lds, const XcdBarrier& bar, int G, int blk, const int wv) {
#define WSP(off) ((bf16*)(ws + (off)))
    unsigned char* wl = ws + WS_WTS + (size_t)l * WTS_LAYER;
    float* SSQ = (float*)(ws + WS_SSQ);
    if (l == 0) { PHASE_IDS(); const float* xcur = KIN(0);
      int m = gw;
      for (; m + NGW < MTOK; m += 2 * NGW) rms_rows2_to_bf16(xcur + (size_t)m * DM, xcur + (size_t)(m + NGW) * DM, WSP(WS_H) + (size_t)m * DM, WSP(WS_H) + (size_t)(m + NGW) * DM, ws + WS_H8B + (size_t)m * DM, ws + WS_H8B + (size_t)(m + NGW) * DM, lane);
      if (m < MTOK) rms_row_to_bf16(xcur + (size_t)m * DM, WSP(WS_H) + (size_t)m * DM, ws + WS_H8B + (size_t)m * DM, lane);
      GRID_BAR(); }
    { pg8::Gemm g{WSP(WS_H), (const bf16*)(wl + WO_IN), MTOK, INA, DM}; pg8::StaticOrder S; S.init(MTOK, INA, G, blk);
      pg8::EpiIn<(l > 0), 0> E{WSP(WS_Q), WSP(WS_KV), WSP(WS_G), WSP(WS_Z), WSP(WS_SM), SSQ + (size_t)(l > 0 ? 2 * l - 1 : 0) * MTOK * 16, -1, (LAS f32x4*)(lds + 136 * 1024), 1.0f};
      pg8::gemm_phase<pg8::EpiIn<(l > 0), 0>, pg8::StaticOrder, true, true>(lds, g, S, E, wv); }
    { pg8::Gemm g{(const bf16*)(ws + WS_H8B), (const bf16*)(wl + WO_IN + (size_t)INA * DM * 2), MTOK, INB, DM}; pg8::StaticOrder S; S.init(MTOK, INB, G, blk);
      pg8::EpiIn<(l > 0), 1> E{WSP(WS_Q), WSP(WS_KV), WSP(WS_G), WSP(WS_Z), WSP(WS_SM), SSQ + (size_t)(l > 0 ? 2 * l - 1 : 0) * MTOK * 16, -1, (LAS f32x4*)(lds + 136 * 1024), 1.0f / 1024.0f};
      pg8::gemm_phase<pg8::EpiIn<(l > 0), 1>, pg8::StaticOrder, true, true, true>(lds, g, S, E, wv); }
    GRID_BAR();
    { const int kvsel = (blk >> 6) & 1;
      pg8::Gemm g{WSP(WS_KV) + (size_t)kvsel * (NB * HKV * SEQ * DH), (const bf16*)(wl + (kvsel ? WO_W1V : WO_W1K)), 8192, 512, 1024}; cmp::OneUnit S{blk};
      pg8::EpiPlain<false> E{WSP(WS_P) + (size_t)kvsel * 8192 * 512, 512, nullptr};
      pg8::gemm_phase<pg8::EpiPlain<false>, cmp::OneUnit, true, true>(lds, g, S, E, wv); }
    { PHASE_IDS();
      gdn::pre_phase(WSP(WS_G), WSP(WS_SM), KIN(12) + l * 4 * 1536, KIN(13) + l * GH, KIN(14) + l * GH, ws + WS_GP, (float*)(ws + WS_GL), lds, blk, G, tid); }
    GRID_BAR();
    { PHASE_IDS(); cmp::post(WSP(WS_P), (const float*)(ws + WS_CTL) + CW_B1P + l * 2 * 2048, (const bf16*)(wl + WO_MISC), WSP(WS_KC), lds, blk, tid);
      gdn::scan_phase(ws + WS_GP, (const float*)(ws + WS_GL), WSP(WS_G), lds, blk, G, tid); }
    GRID_BAR();
    { PHASE_IDS(); nsa::phase(WSP(WS_Q), WSP(WS_KV), WSP(WS_KC), WSP(WS_SM), WSP(WS_G), WSP(WS_Z), WSP(WS_MIX), lds, blk, G, tid); }
    GRID_BAR();
    { pg8::Gemm g{WSP(WS_MIX), (const bf16*)(wl + WO_OUT), MTOK, DM, DM}; pg8::StaticOrder S; S.init(MTOK, DM, G, blk);
      pg8::EpiResSq<(l == 0), true> E{(l == 0) ? (const void*)KIN(0) : (const void*)WSP(WS_H), WSP(WS_H), SSQ + (size_t)(2 * l) * MTOK * 16, ws + WS_H8, 1.0f};
      pg8::gemm_phase<pg8::EpiResSq<(l == 0), true>, pg8::StaticOrder, true, true>(lds, g, S, E, wv); }
    GRID_BAR();
    { pg8::Gemm g{(const bf16*)(ws + WS_H8), (const bf16*)(wl + WO_UP), MTOK, FF2, DM}; pg8::StaticOrder S; S.init(MTOK, FF2, G, blk);
      pg8::EpiConv<true> E{WSP(WS_ACT), KIN(19) + l * 3 * FF2, SSQ + (size_t)(2 * l) * MTOK * 16, (float*)(ws + WS_FB), (float*)(ws + WS_HB), (LAS float*)(lds + 128 * 1024), -1, (LAS f32x4*)(lds + 136 * 1024), (LAS float*)(lds + 152 * 1024)};
      pg8::gemm_phase<pg8::EpiConv<true>, pg8::StaticOrder, true, true, true, true>(lds, g, S, E, wv); }
    GRID_BAR();
    { PHASE_IDS(); ffn_seam_fixup((const float*)(ws + WS_FB), (const float*)(ws + WS_HB), KIN(19) + l * 3 * FF2, WSP(WS_ACT), blk * (NWAVES * 64) + tid, G * NWAVES * 64); }
    GRID_BAR();
    { pg8::Gemm g{WSP(WS_ACT), (const bf16*)(wl + WO_DN), MTOK, DM, FF}; pg8::StaticOrder S; S.init(MTOK, DM, G, blk);
      pg8::EpiResSq<false, (l + 1 < NLAYER)> E{(const void*)WSP(WS_H), WSP(WS_H), SSQ + (size_t)(2 * l + 1) * MTOK * 16, ws + WS_H8B, 1.0f / 2048.0f};
      pg8::gemm_phase<pg8::EpiResSq<false, (l + 1 < NLAYER)>, pg8::StaticOrder, true, true, true>(lds, g, S, E, wv); }
    GRID_BAR();
}

__global__ void __launch_bounds__(NWAVES * 64, 2) fwd(Args a) {
    extern __shared__ __attribute__((aligned(16))) unsigned char lds_raw[];
    LAS unsigned char* lds = (LAS unsigned char*)lds_raw;
    const int G = gridDim.x, blk = blockIdx.x;
    const int wv = __builtin_amdgcn_readfirstlane(threadIdx.x >> 6);
    unsigned char* ws = KWS();
    volatile LAS unsigned* MISC = (volatile LAS unsigned*)(lds + MISC_OFF);
    for (int u = wv * 64 + LANE_ID(); u < (LDS_BYTES - MISC_OFF) / 4; u += NWAVES * 64) MISC[u] = 0u;
    __syncthreads();
    XcdBarrier bar = xcd_barrier_post((unsigned*)(ws + WS_CTL) + CW_BAR, MISC + 8, wv == 0 && LANE_ID() == 0);

    {
        PHASE_IDS();
        LAS float* gv = (LAS float*)(lds + 128 * 1024);
        for (int i = tid; i < NLAYER * 1024; i += NWAVES * 64) { const int l = i >> 10, k = i & 1023; gv[i] = (k < 512) ? KIN(11)[l * 512 + k] : KIN(15)[l * 128 + ((k - 512) & 127)]; }
        __syncthreads();
        if (blk < 32) {
            const int combo = blk >> 3, ksl = blk & 7, ll = combo >> 1, kv = combo & 1, c = tid & 255, kh = tid >> 8;
            const float* w1 = (kv ? KIN(8) : KIN(5)) + (size_t)ll * 2048 * 256; const float* pos = (kv ? KIN(4) : KIN(3)) + ll * 2048;
            float acc = (ksl == 0 && kh == 0) ? ((kv ? KIN(9) : KIN(6))[ll * 256 + c]) : 0.f;
            const int kbeg = ksl * 256 + kh * 128;
#pragma unroll 8
            for (int k = kbeg; k < kbeg + 128; ++k) acc += pos[k] * w1[(size_t)k * 256 + c];
            LAS float* red = (LAS float*)(lds + 136 * 1024);
            if (kh == 1) red[c] = acc;
            __syncthreads();
            if (kh == 0) ((float*)(ws + WS_CTL) + CW_B1P)[(combo * 8 + ksl) * 256 + c] = acc + red[c];
        }
        LAS float* scr = (LAS float*)(lds + wave * 16384);
        constexpr int I_INA = 16 * (INA / 32), I_INB = 16 * (INB / 32), I_IN = I_INA + I_INB, I_OUT = 16 * 32, I_UP = 16 * (FF2 / 32), I_DN = (FF / 64) * 32, I_W1 = 2 * 2 * 128, I_W2 = 2 * 8, I_L = I_IN + I_OUT + I_UP + I_DN + I_W1 + I_W2;
        for (int it = gw; it < NLAYER * I_L; it += NGW) {
            const int l = it / I_L; int r = it % I_L; unsigned char* wl = ws + WS_WTS + (size_t)l * WTS_LAYER;
            if (r < I_INA) { const int nbk = INA / 32, kb = r / nbk, nb = r % nbk, n = nb * 32 + (lane & 31);
                tp_item(KIN(2) + (size_t)l * DM * INW, INW, kb * 64, win_srccol_a(n), n < 512 ? QSCALE : 1.0f, KIN(1) + l * DM, (bf16*)(wl + WO_IN), DM, nb * 32, scr, lane); continue; }
            if (r < I_IN) { const int r2 = r - I_INA, nbk = INB / 32, kb = r2 / nbk, nb = r2 % nbk, n = nb * 32 + (lane & 31);
                tp_item(KIN(2) + (size_t)l * DM * INW, INW, kb * 64, win_srccol_b(n), 1.0f, KIN(1) + l * DM, (bf16*)(wl + WO_IN + (size_t)INA * DM * 2), DM, nb * 32, scr, lane, true); continue; }
            r -= I_IN;
            if (r < I_OUT) { const int kb = r / 32, nb = r % 32;
                tp_item(KIN(16) + (size_t)l * DM * DM, DM, kb * 64, nb * 32 + (lane & 31), 1.0f, (const float*)(gv + l * 1024), (bf16*)(wl + WO_OUT), DM, nb * 32, scr, lane); continue; }
            r -= I_OUT;
            if (r < I_UP) { const int nbk = FF2 / 32, kb = r / nbk, nb = r % nbk;
                const int n = nb * 32 + (lane & 31), pnn = n >> 8, rr = n & 255;
                tp_item(KIN(18) + (size_t)l * DM * FF2, FF2, kb * 64, rr < 128 ? 128 * pnn + rr : FF + 128 * pnn + (rr - 128), 1.0f, KIN(17) + l * DM, (bf16*)(wl + WO_UP), DM, nb * 32, scr, lane, true); continue; }
            r -= I_UP;
            if (r < I_DN) { const int kb = r / 32, nb = r % 32;
                tp_item(KIN(20) + (size_t)l * FF * DM, DM, kb * 64, nb * 32 + (lane & 31), 1.0f, nullptr, (bf16*)(wl + WO_DN), FF, nb * 32, scr, lane, true); continue; }
            r -= I_DN;
            if (r < I_W1) { const int kv = r >> 8, hf = (r >> 7) & 1, kb = (r & 127) >> 3, nb = r & 7;
                tp_item((kv ? KIN(8) : KIN(5)) + (size_t)l * 2048 * 256 + (size_t)hf * 1024 * 256, 256, kb * 64, nb * 32 + (lane & 31), 1.0f, nullptr, (bf16*)(wl + (kv ? WO_W1V : WO_W1K)), 1024, hf * 256 + nb * 32, scr, lane); continue; }
            r -= I_W1;
            { const int kv = r >> 3, kb = (r & 7) >> 1, nb = r & 1;
                tp_item((kv ? KIN(10) : KIN(7)) + (size_t)l * 256 * 64, 64, kb * 64, nb * 32 + (lane & 31), 1.0f, nullptr, (bf16*)(wl + WO_MISC) + kv * 64 * 256, 256, nb * 32, scr, lane); }
        }
    }

    layer_body<0>(ws, lds, bar, G, blk, wv);
    layer_body<1>(ws, lds, bar, G, blk, wv);
    { PHASE_IDS(); float* xo = KOUT(); const float* gf = KIN(21);
      const float* sq = (const float*)(ws + WS_SSQ) + (size_t)3 * MTOK * 16;
      f32x4 gq[4];
#pragma unroll
      for (int j = 0; j < 4; ++j) gq[j] = ((const f32x4*)gf + lane)[64 * j];
      int m = gw;
      for (; m + NGW < MTOK; m += 2 * NGW) {
          const unsigned long long* x0 = (const unsigned long long*)((const bf16*)(ws + WS_H) + (size_t)m * DM) + lane; const unsigned long long* x1 = (const unsigned long long*)((const bf16*)(ws + WS_H) + (size_t)(m + NGW) * DM) + lane;
          unsigned long long a0[4], a1[4];
#pragma unroll
          for (int j = 0; j < 4; ++j) { a0[j] = x0[64 * j]; a1[j] = x1[64 * j]; }
          const float r0 = pg8::row_rstd(sq, m), r1 = pg8::row_rstd(sq, m + NGW);
          f32x4* o0 = (f32x4*)(xo + (size_t)m * DM) + lane; f32x4* o1 = (f32x4*)(xo + (size_t)(m + NGW) * DM) + lane;
#pragma unroll
          for (int j = 0; j < 4; ++j) { const unsigned l0 = (unsigned)a0[j], h0 = (unsigned)(a0[j] >> 32), l1 = (unsigned)a1[j], h1 = (unsigned)(a1[j] >> 32);
              o0[64 * j] = (f32x4){bflo(l0), bfhi(l0), bflo(h0), bfhi(h0)} * r0 * gq[j]; o1[64 * j] = (f32x4){bflo(l1), bfhi(l1), bflo(h1), bfhi(h1)} * r1 * gq[j]; } }
      if (m < MTOK) final_norm_row((const bf16*)(ws + WS_H) + (size_t)m * DM, xo + (size_t)m * DM, gf, pg8::row_rstd(sq, m), lane); }
}

extern "C" void kernel_launch(void* const* d_in, const int* in_sizes, int n_in, void* d_out, int out_size, void* d_ws, size_t ws_size, hipStream_t stream) {
    static int grid = 0;
    if (grid == 0) {
        if (n_in != 22 || in_sizes[0] != MTOK * DM || out_size != MTOK * DM || ws_size < WS_END) {
            fprintf(stderr, "kernel_launch: unexpected shapes (n_in %d, in0 %d, out %d, ws %zu, need %zu); nothing launched\n", n_in, n_in > 0 ? in_sizes[0] : -1, out_size, ws_size, (size_t)WS_END); grid = -1; return; }
        int dev = 0, cus = 0, per_cu = 0;
        if (hipGetDevice(&dev) != hipSuccess || hipDeviceGetAttribute(&cus, hipDeviceAttributeMultiprocessorCount, dev) != hipSuccess) { grid = -1; return; }
        if (hipFuncSetAttribute((const void*)fwd, hipFuncAttributeMaxDynamicSharedMemorySize, LDS_BYTES) != hipSuccess) { fprintf(stderr, "kernel_launch: hipFuncSetAttribute failed\n"); grid = -1; return; }
        if (hipOccupancyMaxActiveBlocksPerMultiprocessor(&per_cu, (const void*)fwd, NWAVES * 64, LDS_BYTES) != hipSuccess || per_cu < 1)
            fprintf(stderr, "kernel_launch: note: occupancy query reports %d workgroups per CU\n", per_cu);
        (void)hipGetLastError();
        grid = cus;
    }
    if (grid < 0) return;
    if (hipMemsetAsync((char*)d_ws + WS_CTL, 0, CTL_ZERO_BYTES, stream) != hipSuccess) { fprintf(stderr, "kernel_launch: memset failed\n"); return; }
    Args a{};
    for (int i = 0; i < 22; ++i) a.in[i] = (const float*)d_in[i];
    a.out = (float*)d_out; a.ws = (unsigned char*)d_ws;
    hipLaunchKernelGGL(fwd, dim3(grid), dim3(NWAVES * 64), LDS_BYTES, stream, a);
    const hipError_t le = hipPeekAtLastError();
    if (le != hipSuccess) fprintf(stderr, "kernel_launch: launch failed: %s\n", hipGetErrorName(le));
}
```

```cpp
#include <hip/hip_runtime.h>
#include <cstdio>
#include <cstdint>
namespace pg8 {
#define PG8_LAS __attribute__((address_space(3)))
typedef unsigned short bf16_t;
typedef short bf16x8 __attribute__((ext_vector_type(8)));
typedef float f32x4 __attribute__((ext_vector_type(4)));
typedef unsigned u32x4 __attribute__((ext_vector_type(4)));
typedef int i32x4v __attribute__((ext_vector_type(4)));
typedef int i32x8v __attribute__((ext_vector_type(8)));
constexpr int BM = 256, BK = 64, HALF = 128, HTB = HALF * BK * 2  , STAGE_BYTES = 8 * HTB, NXCD = 8, WGM = 8;

__host__ __device__ __forceinline__ int lds_byte(int r, int c) { const int st = (r >> 4) * 2 + (c >> 5), rr = r & 15, cc = c & 31, ob = rr * 64 + cc * 2; return st * 1024 + (ob ^ (((ob >> 9) & 1) << 5)); }
__host__ __device__ __forceinline__ void stage_rc(int b, int& R, int& C) { const int st = b / 1024, sb = b % 1024, swz = sb ^ (((sb >> 9) & 1) << 5); R = (st >> 1) * 16 + swz / 64; C = (st & 1) * 32 + (swz % 64) / 2; }
__host__ __device__ __forceinline__ int perm32(int rho) { const int n = rho >> 4, i = rho & 15; return 8 * (i >> 2) + 4 * n + (i & 3); }

struct Unit { int pm, pn; };
struct Gemm { const bf16_t* A; const bf16_t* Bt; int M, N, K; };

struct StaticOrder {
    int nM, nN, nwg, G, c;
    __host__ __device__ void init(int M, int N, int G_, int c_) { nM = M / BM; nN = N / BM; nwg = nM * nN; G = G_; c = c_; }
    __host__ __device__ bool next(int i, Unit& u) const {
        const long L = (long)i * G + c; if (L >= nwg) return false;
        int wgid = (int)L; { const int q = nwg / NXCD, r = nwg % NXCD, xcd = wgid % NXCD, off = wgid / NXCD; wgid = (xcd < r ? xcd * (q + 1) : r * (q + 1) + (xcd - r) * q) + off; }
        const int nig = WGM * nN, gid = wgid / nig, fm = gid * WGM, gsz = (nM - fm) < WGM ? (nM - fm) : WGM;
        u.pm = fm + ((wgid % nig) % gsz); u.pn = (wgid % nig) / gsz; return true;
    }
    __device__ __forceinline__ void a_ready(const Unit&) const {}
    __device__ __forceinline__ void done(const Unit&) const {}
};

__device__ __forceinline__ unsigned pk4_fp8(float a, float b, float c, float d) {
    a = __builtin_fminf(__builtin_fmaxf(a, -448.f), 448.f); b = __builtin_fminf(__builtin_fmaxf(b, -448.f), 448.f); c = __builtin_fminf(__builtin_fmaxf(c, -448.f), 448.f); d = __builtin_fminf(__builtin_fmaxf(d, -448.f), 448.f);
    int p = __builtin_amdgcn_cvt_pk_fp8_f32(a, b, 0, false); p = __builtin_amdgcn_cvt_pk_fp8_f32(c, d, p, true); return (unsigned)p; }
__device__ __forceinline__ unsigned cvt_pk_bf16(float lo, float hi) { unsigned r; asm volatile("v_cvt_pk_bf16_f32 %0, %1, %2" : "=v"(r) : "v"(lo), "v"(hi)); return r; }

template <class Epi, class Sched, bool ALIGN_EPI = false, bool SP2 = false, bool F8 = false, bool APERM = false>
__device__ __forceinline__ void gemm_phase(PG8_LAS unsigned char* lds, const Gemm g, const Sched& S, const Epi& E, const int wv) {
    int wvo_ = wv; asm volatile("" : "+s"(wvo_)); int tid_ = wvo_ * 64 + (int)__builtin_amdgcn_mbcnt_hi(~0u, __builtin_amdgcn_mbcnt_lo(~0u, 0u)); asm volatile("" : "+v"(tid_));
    const int tid = tid_, wid = __builtin_amdgcn_readfirstlane(tid >> 6), lane = tid & 63, wr = wid >> 2, wc = wid & 3, fr = lane & 15, fq = lane >> 4;
    const int K = g.K, pitch = F8 ? K : 2 * K  , nt = pitch / (BK * 2);
    unsigned voffA[2], voffB[2];
#pragma unroll
    for (int i = 0; i < 2; ++i) { int R, C; stage_rc(tid * 16 + i * 8192, R, C); const int Rb = Epi::PERM ? ((R & ~31) + perm32(R & 31)) : R;
        const int Ra = APERM ? ((R & ~63) | ((R & 15) << 2) | ((R >> 4) & 3)) : R; voffA[i] = (unsigned)(Ra * pitch + C * 2); voffB[i] = (unsigned)(Rb * pitch + C * 2); }
    const size_t kstep = (size_t)(BK * 2);
    const size_t hstep = (size_t)HALF * pitch;
    const size_t tstep = 2 * hstep;
    const unsigned ldsw = (unsigned)wid * 1024u;
    const int aoff = lds_byte(wr * 64 + fr, fq * 8), boff = lds_byte(wc * 32 + fr, fq * 8);
#define PG8_SA(b, h) (((b) * 2 + (h)) * HTB)
#define PG8_SB(b, h) ((4 + (b) * 2 + (h)) * HTB)
#define PG8_STAGE(bufoff, gbase, voff) do { _Pragma("unroll") for (int _i = 0; _i < 2; ++_i) \
        __builtin_amdgcn_global_load_lds((const unsigned*)((const char*)(gbase) + (voff)[_i]), (PG8_LAS unsigned*)(lds + (bufoff) + ldsw + _i * 8192), 16, 0, 0); } while (0)
#define PG8_LDA(dst, b, h) do { _Pragma("unroll") for (int m = 0; m < 4; ++m) _Pragma("unroll") for (int k = 0; k < 2; ++k) dst[m][k] = *(const PG8_LAS bf16x8*)(lds + PG8_SA(b, h) + aoff + m * 2048 + k * 1024); } while (0)
#define PG8_LDB(dst, b, h) do { _Pragma("unroll") for (int n = 0; n < 2; ++n) _Pragma("unroll") for (int k = 0; k < 2; ++k) dst[n][k] = *(const PG8_LAS bf16x8*)(lds + PG8_SB(b, h) + boff + n * 2048 + k * 1024); } while (0)
#define PG8_CAT8(x, y) __builtin_shufflevector(__builtin_bit_cast(i32x4v, x), __builtin_bit_cast(i32x4v, y), 0, 1, 2, 3, 4, 5, 6, 7)
#define PG8_MMA(ai, bj, At, Bt) do { __builtin_amdgcn_s_setprio(1); _Pragma("unroll") for (int m = 0; m < 4; ++m) _Pragma("unroll") for (int n = 0; n < 2; ++n) { \
        if constexpr (F8) asm volatile("v_mfma_scale_f32_16x16x128_f8f6f4 %0, %1, %2, %0, %3, %3 op_sel_hi:[0,0,0]" : "+v"(acc[ai][bj][m][n]) : "v"(PG8_CAT8(Bt[n][0], Bt[n][1])), "v"(PG8_CAT8(At[m][0], At[m][1])), "v"(scl8)); \
        else { _Pragma("unroll") for (int k = 0; k < 2; ++k) acc[ai][bj][m][n] = __builtin_amdgcn_mfma_f32_16x16x32_bf16(Bt[n][k], At[m][k], acc[ai][bj][m][n], 0, 0, 0); } } __builtin_amdgcn_s_setprio(0); } while (0)
#define PG8_MMA0(ai, bj, At, Bt) do { __builtin_amdgcn_s_setprio(1); _Pragma("unroll") for (int m = 0; m < 4; ++m) _Pragma("unroll") for (int n = 0; n < 2; ++n) { \
        if constexpr (F8) asm volatile("v_mfma_scale_f32_16x16x128_f8f6f4 %0, %1, %2, 0, %3, %3 op_sel_hi:[0,0,0]" : "=&v"(acc[ai][bj][m][n]) : "v"(PG8_CAT8(Bt[n][0], Bt[n][1])), "v"(PG8_CAT8(At[m][0], At[m][1])), "v"(scl8)); \
        else { acc[ai][bj][m][n] = __builtin_amdgcn_mfma_f32_16x16x32_bf16(Bt[n][0], At[m][0], (f32x4){0.f, 0.f, 0.f, 0.f}, 0, 0, 0); acc[ai][bj][m][n] = __builtin_amdgcn_mfma_f32_16x16x32_bf16(Bt[n][1], At[m][1], acc[ai][bj][m][n], 0, 0, 0); } } __builtin_amdgcn_s_setprio(0); } while (0)
#define PG8_WAIT_V(n) asm volatile("s_waitcnt vmcnt(" #n ")" ::: "memory")
#define PG8_WAIT_L(n) asm volatile("s_waitcnt lgkmcnt(" #n ")" ::: "memory")
#define PG8_BAR __builtin_amdgcn_s_barrier()
#define PG8_SCHED __builtin_amdgcn_sched_barrier(0)
    Unit cur, nxt; int ui = 0;
    int scl8 = 0x7f7f7f7f; asm volatile("" : "+v"(scl8));
    if (!S.next(0, cur)) return;
    f32x4 acc[2][2][4][2];
#pragma unroll
    for (int a = 0; a < 2; ++a)
#pragma unroll
        for (int b = 0; b < 2; ++b)
#pragma unroll
            for (int m = 0; m < 4; ++m)
#pragma unroll
                for (int n = 0; n < 2; ++n) acc[a][b][m][n] = (f32x4){0.f, 0.f, 0.f, 0.f};
    bf16x8 At[4][2], B0[2][2], B1[2][2];
    const char* cA = (const char*)g.A + (size_t)cur.pm * tstep; const char* cB = (const char*)g.Bt + (size_t)cur.pn * tstep;
    S.a_ready(cur);
    if constexpr (SP2) {
        PG8_STAGE(PG8_SB(0, 0), cB, voffB); PG8_STAGE(PG8_SB(0, 1), cB + hstep, voffB); PG8_STAGE(PG8_SA(0, 0), cA, voffA); PG8_STAGE(PG8_SA(0, 1), cA + hstep, voffA);
        if (wr == 1) PG8_BAR;
        PG8_WAIT_V(2); PG8_BAR;
        PG8_STAGE(PG8_SB(1, 0), cB + kstep, voffB); PG8_STAGE(PG8_SA(1, 0), cA + kstep, voffA); PG8_STAGE(PG8_SB(1, 1), cB + hstep + kstep, voffB);
        PG8_WAIT_V(6); PG8_BAR;
    } else {
        PG8_STAGE(PG8_SB(0, 0), cB, voffB); PG8_STAGE(PG8_SA(0, 0), cA, voffA); PG8_STAGE(PG8_SB(0, 1), cB + hstep, voffB); PG8_STAGE(PG8_SA(0, 1), cA + hstep, voffA);
        if (wr == 1) PG8_BAR;
        PG8_WAIT_V(4); PG8_BAR;
        PG8_STAGE(PG8_SB(1, 0), cB + kstep, voffB); PG8_STAGE(PG8_SA(1, 0), cA + kstep, voffA); PG8_STAGE(PG8_SB(1, 1), cB + hstep + kstep, voffB);
        PG8_WAIT_V(6); PG8_BAR;
    }
    for (;;) {
        const bool has_next = S.next(ui + 1, nxt);
        const char* nA = has_next ? (const char*)g.A + (size_t)nxt.pm * tstep : cA; const char* nB = has_next ? (const char*)g.Bt + (size_t)nxt.pn * tstep : cB;
        for (int t = 0; t < nt; t += 2) {
            const bool last = (t == nt - 2);
            const char* a1 = cA + (size_t)(t + 1) * kstep;
            const char* a2 = last ? nA : cA + (size_t)(t + 2) * kstep; const char* b2 = last ? nB : cB + (size_t)(t + 2) * kstep;
            const char* a3 = a2 + kstep; const char* b3 = b2 + kstep;
            if (last && has_next) S.a_ready(nxt);
            if constexpr (SP2) {
            PG8_LDB(B0, 0, 0); PG8_LDB(B1, 0, 1); PG8_SCHED; PG8_LDA(At, 0, 0); PG8_STAGE(PG8_SA(1, 1), a1 + hstep, voffA);
            PG8_WAIT_V(8); PG8_WAIT_L(0); PG8_BAR; if (F8 && t == 0) { PG8_MMA0(0, 0, At, B0); PG8_MMA0(0, 1, At, B1); } else { PG8_MMA(0, 0, At, B0); PG8_MMA(0, 1, At, B1); } PG8_BAR; PG8_SCHED;
            PG8_LDA(At, 0, 1); PG8_STAGE(PG8_SB(0, 0), b2, voffB); PG8_STAGE(PG8_SB(0, 1), b2 + hstep, voffB); PG8_STAGE(PG8_SA(0, 0), a2, voffA);
            PG8_WAIT_V(8); PG8_WAIT_L(0); PG8_BAR; if (F8 && t == 0) { PG8_MMA0(1, 0, At, B0); PG8_MMA0(1, 1, At, B1); } else { PG8_MMA(1, 0, At, B0); PG8_MMA(1, 1, At, B1); } PG8_BAR; PG8_SCHED;
            PG8_LDB(B0, 1, 0); PG8_LDB(B1, 1, 1); PG8_SCHED; PG8_LDA(At, 1, 0); PG8_STAGE(PG8_SA(0, 1), a2 + hstep, voffA);
            PG8_WAIT_V(8); PG8_WAIT_L(0); PG8_BAR; PG8_MMA(0, 0, At, B0); PG8_MMA(0, 1, At, B1); PG8_BAR; PG8_SCHED;
            PG8_LDA(At, 1, 1); PG8_STAGE(PG8_SB(1, 0), b3, voffB); PG8_STAGE(PG8_SB(1, 1), b3 + hstep, voffB); PG8_STAGE(PG8_SA(1, 0), a3, voffA);
            PG8_WAIT_V(8); PG8_WAIT_L(0); PG8_BAR; PG8_MMA(1, 0, At, B0); PG8_MMA(1, 1, At, B1); PG8_BAR; PG8_SCHED;
            } else {
            PG8_LDB(B0, 0, 0); PG8_SCHED; PG8_LDA(At, 0, 0); PG8_STAGE(PG8_SA(1, 1), a1 + hstep, voffA);
            PG8_WAIT_L(8); PG8_BAR; PG8_WAIT_L(0); PG8_MMA(0, 0, At, B0); PG8_BAR; PG8_SCHED;
            PG8_LDB(B1, 0, 1); PG8_STAGE(PG8_SB(0, 0), b2, voffB);
            PG8_BAR; PG8_WAIT_L(0); PG8_MMA(0, 1, At, B1); PG8_BAR;
            PG8_LDA(At, 0, 1); PG8_STAGE(PG8_SA(0, 0), a2, voffA);
            PG8_BAR; PG8_WAIT_L(0); PG8_MMA(1, 0, At, B0); PG8_BAR; PG8_SCHED;
            PG8_STAGE(PG8_SB(0, 1), b2 + hstep, voffB);
            PG8_WAIT_V(6); PG8_BAR; PG8_MMA(1, 1, At, B1); PG8_BAR;
            PG8_LDB(B0, 1, 0); PG8_SCHED; PG8_LDA(At, 1, 0); PG8_STAGE(PG8_SA(0, 1), a2 + hstep, voffA);
            PG8_WAIT_L(8); PG8_BAR; PG8_WAIT_L(0); PG8_MMA(0, 0, At, B0); PG8_BAR; PG8_SCHED;
            PG8_LDB(B1, 1, 1); PG8_STAGE(PG8_SB(1, 0), b3, voffB);
            PG8_BAR; PG8_WAIT_L(0); PG8_MMA(0, 1, At, B1); PG8_BAR;
            PG8_LDA(At, 1, 1); PG8_STAGE(PG8_SA(1, 0), a3, voffA);
            PG8_BAR; PG8_WAIT_L(0); PG8_MMA(1, 0, At, B0); PG8_BAR; PG8_SCHED;
            PG8_STAGE(PG8_SB(1, 1), b3 + hstep, voffB);
            PG8_WAIT_V(6); PG8_BAR; PG8_MMA(1, 1, At, B1); PG8_BAR;
            }
        }
        if constexpr (ALIGN_EPI) { if (wr == 0) PG8_BAR; }
        if constexpr (F8) asm volatile("s_nop 15\n\ts_nop 7" ::: "memory");
        if constexpr (!Epi::AFTER_DRAIN) { E(acc, cur, wr, wc, fr, fq); S.done(cur); }
        if (!has_next) break;
        if constexpr (!(SP2 && F8))
#pragma unroll
        for (int a = 0; a < 2; ++a)
#pragma unroll
            for (int b = 0; b < 2; ++b)
#pragma unroll
                for (int m = 0; m < 4; ++m)
#pragma unroll
                    for (int n = 0; n < 2; ++n) acc[a][b][m][n] = (f32x4){0.f, 0.f, 0.f, 0.f};
        cur = nxt; cA = nA; cB = nB; ++ui;
        if constexpr (ALIGN_EPI) { if (wr == 1) PG8_BAR; }
    }
    PG8_WAIT_V(0);
    if constexpr (!ALIGN_EPI) { if (wr == 0) PG8_BAR; }
    PG8_BAR;
    if constexpr (Epi::AFTER_DRAIN) { E.fused(acc, cur, wr, wc, fr, fq, lds, wid, lane); S.done(cur); }
#undef PG8_SA
#undef PG8_SB
#undef PG8_STAGE
#undef PG8_LDA
#undef PG8_LDB
#undef PG8_MMA
#undef PG8_CAT8
#undef PG8_WAIT_V
#undef PG8_WAIT_L
#undef PG8_BAR
#undef PG8_SCHED
}
}

constexpr int NB = 32, SEQ = 2048, DM = 1024, MTOK = NB * SEQ, NLAYER = 2;
constexpr int HQ = 8, HKV = 2, DH = 64;
constexpr int GH = 4, GD = 128;
constexpr int INW = 3360, INA = 768, INB = 2816, FF = 2816, FF2 = 5632;
constexpr float EPS = 1e-6f;
constexpr float QSCALE = 0.125f * 1.4426950408889634f;
constexpr int NWAVES = 8;

constexpr size_t MiB = 1u << 20;
constexpr size_t WS_CTL = 0, CTL_ZERO_BYTES = 1 * MiB;
constexpr size_t WS_WTS = 2 * MiB, WTS_LAYER = 30 * MiB;
constexpr size_t WO_IN = 0, WO_OUT = 7 * MiB, WO_UP = 9 * MiB, WO_DN = 20 * MiB, WO_W1K = 26 * MiB, WO_W1V = 27 * MiB, WO_MISC = 28 * MiB;
constexpr size_t WS_H = 65 * MiB;
constexpr size_t WS_H8 = 193 * MiB;
constexpr size_t WS_H8B = 741 * MiB;
constexpr size_t KV_PIECE_BYTES = (size_t)32 * 2 * 2048 * 64 * 2;
constexpr size_t WS_Q = 193 * MiB;
constexpr size_t WS_KV = 257 * MiB;
constexpr size_t WS_G = 353 * MiB;
constexpr size_t WS_Z = 545 * MiB;
constexpr size_t WS_SM = 609 * MiB;
constexpr size_t WS_GP = 613 * MiB;
constexpr size_t WS_MIX = 613 * MiB;
constexpr size_t WS_P = 901 * MiB;
constexpr size_t WS_KC = 917 * MiB;
constexpr size_t WS_ACT = 545 * MiB;
constexpr size_t WS_GL = 919 * MiB;
constexpr size_t WS_SSQ = 920 * MiB;
constexpr size_t WS_FB = 936 * MiB, WS_HB = 948 * MiB;
constexpr size_t WS_END = 960 * MiB;
static_assert(WS_ACT + (size_t)MTOK * FF * 2 <= WS_P, "ACT overlays Z .. GP");
constexpr int CW_BAR = 4096;
constexpr int CW_B1P = 16384;

constexpr int LDS_BYTES = 160 * 1024;
constexpr int MISC_OFF = 159 * 1024;

#define GAS __attribute__((address_space(1)))
#define LAS __attribute__((address_space(3)))
typedef unsigned short bf16;
typedef unsigned v4u __attribute__((ext_vector_type(4)));
typedef float f32x4 __attribute__((ext_vector_type(4)));
#define LDS_WAIT() asm volatile("s_waitcnt lgkmcnt(0)" ::: "memory")
#define VM_WAIT() asm volatile("s_waitcnt vmcnt(0)" ::: "memory")
typedef float f32x2c_t __attribute__((ext_vector_type(2))); typedef __bf16 bf16x2c_t __attribute__((ext_vector_type(2)));
__device__ __forceinline__ unsigned pk2(float lo, float hi) { const f32x2c_t v = {lo, hi}; return __builtin_bit_cast(unsigned, __builtin_convertvector(v, bf16x2c_t)); }
__device__ __forceinline__ unsigned f2bf(float f) { return pk2(f, 0.f) & 0xffffu; }
__device__ __forceinline__ float bf2f(bf16 v) { return __uint_as_float(((unsigned)v) << 16); }
__device__ __forceinline__ float bflo(unsigned u) { return __uint_as_float(u << 16); }
__device__ __forceinline__ float bfhi(unsigned u) { return __uint_as_float(u & 0xffff0000u); }
__device__ __forceinline__ float wave_sum(float v) {
#pragma unroll
    for (int o = 1; o < 64; o <<= 1) v += __shfl_xor(v, o);
    return v;
}
__device__ __forceinline__ float wave_max(float v) {
#pragma unroll
    for (int o = 1; o < 64; o <<= 1) v = fmaxf(v, __shfl_xor(v, o));
    return v;
}
__device__ __forceinline__ float siluf(float x) { return x * __builtin_amdgcn_rcpf(1.0f + __expf(-x)); }
__device__ __forceinline__ float sigmf(float x) { return __builtin_amdgcn_rcpf(1.0f + __expf(-x)); }
__device__ __forceinline__ float softplusf(float x) { return fmaxf(x, 0.f) + log1pf(__expf(-fabsf(x))); }
__device__ __forceinline__ float gelu_tanh(float x) { const float y = 0.7978845608028654f * (x + 0.044715f * x * x * x); const float th = 1.0f - 2.0f / (__expf(2.0f * y) + 1.0f); return 0.5f * x * (1.0f + th); }

#define XB_TMO      128
#define XB_XCNT(j)  (256  + 64 * (j))
#define XB_XSUB(j)  (1280 + 64 * (j))
#define XB_XGEN(j)  (2304 + 64 * (j))
#define XB_TOP      3328
#define XB_TOPGEN   3392
#define XCD_BAR_WORDS 3456
#define XB_SPIN_CAP (1u << 22)
__device__ __forceinline__ unsigned xb_ld(unsigned* p)              { return __hip_atomic_load(p, __ATOMIC_RELAXED, __HIP_MEMORY_SCOPE_AGENT); }
__device__ __forceinline__ unsigned xb_add(unsigned* p, unsigned v) { return __hip_atomic_fetch_add(p, v, __ATOMIC_RELAXED, __HIP_MEMORY_SCOPE_AGENT); }
__device__ __forceinline__ unsigned xb_xcc_id() { return (unsigned)__builtin_amdgcn_s_getreg((3 << 11) | 20) & 0xFu; }
#define XB_SPIN(cond, bar) do { unsigned _sp = 0; while (cond) { __builtin_amdgcn_s_sleep(1); \
    if ((++_sp & 255u) == 0u) { if (xb_ld(&(bar)[XB_TMO])) break; if (_sp > XB_SPIN_CAP) { atomicAdd(&(bar)[XB_TMO], 1u); break; } } } } while (0)
struct XcdBarrier { unsigned* bar; unsigned x; volatile LAS unsigned* st; };
__device__ __forceinline__ XcdBarrier xcd_barrier_post(unsigned* bar, volatile LAS unsigned* st, const bool t0) {
    XcdBarrier b; b.bar = bar; b.x = xb_xcc_id(); b.st = st;
    if (t0) (void)xb_add(&bar[XB_XCNT(b.x)], 1u);
    return b;
}
__device__ __forceinline__ void xcd_barrier_complete(unsigned* bar, unsigned x, unsigned& nloc, unsigned& nx) {
    const unsigned G = gridDim.x * gridDim.y * gridDim.z;
    unsigned sum, cnt, mine, sp = 0u;
    for (;;) {
        sum = 0u; cnt = 0u; mine = 0u;
#pragma unroll
        for (unsigned j = 0; j < 16; ++j) { const unsigned c = xb_ld(&bar[XB_XCNT(j)]); sum += c; cnt += (c > 0u) ? 1u : 0u; mine = (j == x) ? c : mine; }
        if (sum == G) break;
        __builtin_amdgcn_s_sleep(1);
        if ((++sp & 255u) == 0u) { if (xb_ld(&bar[XB_TMO])) break; if (sp > XB_SPIN_CAP) { atomicAdd(&bar[XB_TMO], 1u); break; } }
    }
    nloc = mine > 0u ? mine : 1u; nx = cnt > 0u ? cnt : 1u;
}
__device__ __forceinline__ void xcd_barrier(const XcdBarrier& b, const bool t0) {
    asm volatile("s_waitcnt vmcnt(0)" ::: "memory");
    __syncthreads();
    if (t0) {
        unsigned* bar = b.bar;
        __builtin_amdgcn_s_waitcnt(0);
        unsigned nloc = b.st[0], nx = b.st[1];
        if (nloc == 0u) { xcd_barrier_complete(bar, b.x, nloc, nx); b.st[0] = nloc; b.st[1] = nx; }
        const unsigned old = xb_add(&bar[XB_XSUB(b.x)], 1u);
        const unsigned gen = old / nloc;
        if (old + 1u == (gen + 1u) * nloc) {
            __builtin_amdgcn_fence(__ATOMIC_RELEASE, "agent");
            asm volatile("s_waitcnt vmcnt(0)" ::: "memory");
            const unsigned og = xb_add(&bar[XB_TOP], 1u);
            const unsigned tg = og / nx;
            if (og + 1u == (tg + 1u) * nx) xb_add(&bar[XB_TOPGEN], 1u);
            else XB_SPIN(xb_ld(&bar[XB_TOPGEN]) == tg, bar);
            __builtin_amdgcn_fence(__ATOMIC_ACQUIRE, "agent");
            xb_add(&bar[XB_XGEN(b.x)], 1u);
            asm volatile("s_waitcnt vmcnt(0)" ::: "memory");
        } else {
            XB_SPIN(xb_ld(&bar[XB_XGEN(b.x)]) == gen, bar);
            __builtin_amdgcn_fence(__ATOMIC_ACQUIRE, "agent");
            asm volatile("s_waitcnt vmcnt(0)" ::: "memory");
        }
    }
    __syncthreads();
}

namespace pg8 {
__device__ __forceinline__ float row_rstd(const float* ssqp, int row) {
    const f32x4* p = (const f32x4*)(ssqp + (size_t)row * 16); const f32x4 a = p[0], b = p[1], c = p[2], d = p[3];
    const float s = ((a[0] + a[1]) + (a[2] + a[3])) + ((b[0] + b[1]) + (b[2] + b[3])) + ((c[0] + c[1]) + (c[2] + c[3])) + ((d[0] + d[1]) + (d[2] + d[3]));
    return 1.0f / sqrtf(s * (1.0f / 1024.0f) + 1e-6f); }
__device__ __forceinline__ void rows_rstd(const float* ssqp, int row0, int fq, float (&rs)[2][4], int mstride = 16) {
    f32x4 a[2][4];
#pragma unroll
    for (int ai = 0; ai < 2; ++ai)
#pragma unroll
        for (int m = 0; m < 4; ++m) a[ai][m] = *(const f32x4*)(ssqp + (size_t)(row0 + ai * HALF + m * mstride) * 16 + fq * 4);
#pragma unroll
    for (int ai = 0; ai < 2; ++ai)
#pragma unroll
        for (int m = 0; m < 4; ++m) { float s = (a[ai][m][0] + a[ai][m][1]) + (a[ai][m][2] + a[ai][m][3]); s += __shfl_xor(s, 16); s += __shfl_xor(s, 32); rs[ai][m] = 1.0f / sqrtf(s * (1.0f / 1024.0f) + 1e-6f); }
}
template <bool SCALE, int GRP> struct EpiIn {
    static constexpr bool PERM = true, AFTER_DRAIN = false;
    bf16_t *Q, *KV, *G, *Z, *SM; const float* ssq; mutable int last_pm; PG8_LAS f32x4* rcache;
    float post;
    __device__ __forceinline__ void operator()(const f32x4 (&acc)[2][2][4][2], const Unit& u, int wr, int wc, int fr, int fq) const {
        const int row0 = u.pm * BM + wr * 64 + fr; const int pn = u.pn;
        float rs[2][4];
        if (SCALE) { PG8_LAS f32x4* rc = rcache + 2 * ((wr * 4 + wc) * 64 + (fq * 16 + (fr & 15)));
            if (u.pm != last_pm) { rows_rstd(ssq, row0, fq, rs); last_pm = u.pm; rc[0] = (f32x4){rs[0][0], rs[0][1], rs[0][2], rs[0][3]}; rc[1] = (f32x4){rs[1][0], rs[1][1], rs[1][2], rs[1][3]}; }
            else { const f32x4 a_ = rc[0], b_ = rc[1]; rs[0][0] = a_[0]; rs[0][1] = a_[1]; rs[0][2] = a_[2]; rs[0][3] = a_[3]; rs[1][0] = b_[0]; rs[1][1] = b_[1]; rs[1][2] = b_[2]; rs[1][3] = b_[3]; } }
#pragma unroll
        for (int ai = 0; ai < 2; ++ai)
#pragma unroll
            for (int m = 0; m < 4; ++m) {
                const int row = row0 + ai * HALF + m * 16;
                const float rsr = (SCALE ? rs[ai][m] : 1.0f) * (GRP == 1 ? post : 1.0f);
#pragma unroll
                for (int bj = 0; bj < 2; ++bj) {
                    const int col = pn * BM + bj * HALF + wc * 32 + 8 * fq, c128 = wc * 32 + 8 * fq;
                    const f32x4 v0 = acc[ai][bj][m][0] * rsr, v1 = acc[ai][bj][m][1] * rsr;
                    u32x4 w; w.x = cvt_pk_bf16(v0[0], v0[1]); w.y = cvt_pk_bf16(v0[2], v0[3]); w.z = cvt_pk_bf16(v1[0], v1[1]); w.w = cvt_pk_bf16(v1[2], v1[3]);
                    bf16_t* dst; const int b = row >> 11, sq = row & 2047, hh = (c128 >> 6) & 1, d = c128 & 63;
#define EPIIN_KV(piece) (KV + ((size_t)(((piece) * 32 + b) * 2 + hh) * 2048 + sq) * 64 + d)
#define EPIIN_VT8(piece) do { const int key_ = sq & 63, k32_ = key_ & 31, pos_ = 32 * ((k32_ >> 2) & 1) + 16 * (key_ >> 5) + (k32_ & 3) + 4 * (k32_ >> 3); \
                        unsigned char* vt_ = (unsigned char*)KV + (size_t)(piece) * KV_PIECE_BYTES + ((size_t)(b * 2 + hh) * 2048) * 64 + (size_t)(sq >> 6) * 4096 + d * 64 + pos_; \
                        const unsigned qa_ = pk4_fp8(v0[0] * 4.f, v0[1] * 4.f, v0[2] * 4.f, v0[3] * 4.f), qb_ = pk4_fp8(v1[0] * 4.f, v1[1] * 4.f, v1[2] * 4.f, v1[3] * 4.f); \
                        vt_[0] = (unsigned char)qa_; vt_[64] = (unsigned char)(qa_ >> 8); vt_[128] = (unsigned char)(qa_ >> 16); vt_[192] = (unsigned char)(qa_ >> 24); \
                        vt_[256] = (unsigned char)qb_; vt_[320] = (unsigned char)(qb_ >> 8); vt_[384] = (unsigned char)(qb_ >> 16); vt_[448] = (unsigned char)(qb_ >> 24); } while (0)
#define EPIIN_K8(piece) do { typedef unsigned u32x2_t __attribute__((ext_vector_type(2))); u32x2_t q8_; q8_.x = pk4_fp8(v0[0] * 4.f, v0[1] * 4.f, v0[2] * 4.f, v0[3] * 4.f); q8_.y = pk4_fp8(v1[0] * 4.f, v1[1] * 4.f, v1[2] * 4.f, v1[3] * 4.f); \
                        *(u32x2_t*)((unsigned char*)KV + (size_t)(piece) * KV_PIECE_BYTES + ((size_t)((b * 2 + hh) * 2048 + sq)) * 64 + 32 * ((d >> 3) & 1) + 8 * (d >> 4)) = q8_; } while (0)
                    if (GRP == 0) {
                        if (pn < 2) dst = Q + (size_t)row * 512 + col;
                        else { if (bj == 0) dst = EPIIN_KV(0);
                            else { if (c128 >= 32) continue; dst = SM + (size_t)row * 32 + c128; } }
                    } else {
                        if (pn == 0) { if (bj) { EPIIN_VT8(3); continue; } dst = EPIIN_KV(1); }
                        else if (pn == 1) { if (bj) { EPIIN_K8(2); continue; } EPIIN_VT8(5); continue; }
                        else if (pn < 4) dst = G + (size_t)row * 1536 + (col - 512);
                        else if (pn < 6) dst = G + (size_t)row * 1536 + 1024 + (col - 1024);
                        else if (pn < 8) dst = Z + (size_t)row * 512 + (col - 1536);
                        else if (pn < 10) dst = G + (size_t)row * 1536 + 512 + (col - 2048);
                        else { if (bj == 0) EPIIN_K8(4); continue; }
                    }
#undef EPIIN_KV
#undef EPIIN_K8
#undef EPIIN_VT8
                    *(u32x4*)dst = w;
                }
            }
    }
};
struct EpiRes {
    static constexpr bool PERM = false, AFTER_DRAIN = false;
    const float* res; float* out; int ldc;
    __device__ __forceinline__ void operator()(const f32x4 (&acc)[2][2][4][2], const Unit& u, int wr, int wc, int fr, int fq) const {
        const int row0 = u.pm * BM + wr * 64 + fr, col0 = u.pn * BM + wc * 32 + 4 * fq;
#pragma unroll
        for (int ai = 0; ai < 2; ++ai)
#pragma unroll
            for (int m = 0; m < 4; ++m) { const size_t off = (size_t)(row0 + ai * HALF + m * 16) * ldc + col0;
#pragma unroll
                for (int bj = 0; bj < 2; ++bj)
#pragma unroll
                    for (int n = 0; n < 2; ++n) { const size_t o = off + bj * HALF + n * 16; *(f32x4*)(out + o) = *(const f32x4*)(res + o) + acc[ai][bj][m][n]; } }
    }
};
template <bool SCALE> struct EpiPlain {
    static constexpr bool PERM = true, AFTER_DRAIN = false;
    bf16_t* O; int ldc; const float* ssq;
    __device__ __forceinline__ void operator()(const f32x4 (&acc)[2][2][4][2], const Unit& u, int wr, int wc, int fr, int fq) const {
        const int row0 = u.pm * BM + wr * 64 + fr, col0 = u.pn * BM + wc * 32 + 8 * fq;
        float rsa[2][4];
        if (SCALE) rows_rstd(ssq, row0, fq, rsa);
#pragma unroll
        for (int ai = 0; ai < 2; ++ai)
#pragma unroll
            for (int m = 0; m < 4; ++m) { bf16_t* rowp = O + (size_t)(row0 + ai * HALF + m * 16) * ldc + col0;
                const float rs = SCALE ? rsa[ai][m] : 1.0f;
#pragma unroll
                for (int bj = 0; bj < 2; ++bj) { const f32x4 v0 = acc[ai][bj][m][0] * rs, v1 = acc[ai][bj][m][1] * rs;
                    u32x4 w; w.x = cvt_pk_bf16(v0[0], v0[1]); w.y = cvt_pk_bf16(v0[2], v0[3]); w.z = cvt_pk_bf16(v1[0], v1[1]); w.w = cvt_pk_bf16(v1[2], v1[3]);
                    *(u32x4*)(rowp + bj * HALF) = w; } }
    }
};
template <bool RES_F32, bool W8 = false> struct EpiResSq {
    static constexpr bool PERM = true, AFTER_DRAIN = false;
    const void* res; bf16_t* hb; float* ssq; unsigned char* h8; float cs;
    __device__ __forceinline__ void operator()(const f32x4 (&acc)[2][2][4][2], const Unit& u, int wr, int wc, int fr, int fq) const {
        const int row0 = u.pm * BM + wr * 64 + fr, col0 = u.pn * BM + wc * 32 + 8 * fq;
        constexpr int MB = RES_F32 ? 2 : 4;
#pragma unroll
        for (int ai = 0; ai < 2; ++ai)
#pragma unroll
            for (int mb = 0; mb < 4; mb += MB) {
                u32x4 rbv[MB][2]; f32x4 rfv[MB][2][2];
#pragma unroll
                for (int mm = 0; mm < MB; ++mm)
#pragma unroll
                    for (int bj = 0; bj < 2; ++bj) { const size_t o = (size_t)(row0 + ai * HALF + (mb + mm) * 16) * 1024 + col0 + bj * HALF;
                        if (RES_F32) { rfv[mm][bj][0] = *(const f32x4*)((const float*)res + o); rfv[mm][bj][1] = *(const f32x4*)((const float*)res + o + 4); }
                        else rbv[mm][bj] = *(const u32x4*)((const bf16_t*)res + o); }
                __builtin_amdgcn_sched_barrier(0);
#pragma unroll
                for (int mm = 0; mm < MB; ++mm) { const int m = mb + mm, row = row0 + ai * HALF + m * 16; float ss = 0.f;
#pragma unroll
                    for (int bj = 0; bj < 2; ++bj) { const size_t o = (size_t)row * 1024 + col0 + bj * HALF;
                        f32x4 r0, r1;
                        if (RES_F32) { r0 = rfv[mm][bj][0]; r1 = rfv[mm][bj][1]; }
                        else { const u32x4 rb = rbv[mm][bj];
                            r0 = (f32x4){__uint_as_float(rb.x << 16), __uint_as_float(rb.x & 0xffff0000u), __uint_as_float(rb.y << 16), __uint_as_float(rb.y & 0xffff0000u)};
                            r1 = (f32x4){__uint_as_float(rb.z << 16), __uint_as_float(rb.z & 0xffff0000u), __uint_as_float(rb.w << 16), __uint_as_float(rb.w & 0xffff0000u)}; }
                        const f32x4 v0 = r0 + acc[ai][bj][m][0] * cs, v1 = r1 + acc[ai][bj][m][1] * cs;
                        ss += (v0[0] * v0[0] + v0[1] * v0[1]) + (v0[2] * v0[2] + v0[3] * v0[3]) + (v1[0] * v1[0] + v1[1] * v1[1]) + (v1[2] * v1[2] + v1[3] * v1[3]);
                        u32x4 w; w.x = cvt_pk_bf16(v0[0], v0[1]); w.y = cvt_pk_bf16(v0[2], v0[3]); w.z = cvt_pk_bf16(v1[0], v1[1]); w.w = cvt_pk_bf16(v1[2], v1[3]);
                        *(u32x4*)(hb + o) = w;
                        if (W8) { typedef unsigned u32x2_t __attribute__((ext_vector_type(2))); u32x2_t q; q.x = pk4_fp8(v0[0] * 4.f, v0[1] * 4.f, v0[2] * 4.f, v0[3] * 4.f); q.y = pk4_fp8(v1[0] * 4.f, v1[1] * 4.f, v1[2] * 4.f, v1[3] * 4.f); *(u32x2_t*)(h8 + o) = q; } }
                    ss += __shfl_xor(ss, 16); ss += __shfl_xor(ss, 32);
                    if (fq == 0) ssq[(size_t)row * 16 + u.pn * 4 + wc] = ss; }
            }
    }
};
__device__ __forceinline__ float dpp_ror1(float x) { return __builtin_bit_cast(float, __builtin_amdgcn_mov_dpp(__builtin_bit_cast(int, x), 0x121, 0xf, 0xf, true)); }
__device__ __forceinline__ float dpp_ror2(float x) { return __builtin_bit_cast(float, __builtin_amdgcn_mov_dpp(__builtin_bit_cast(int, x), 0x122, 0xf, 0xf, true)); }
template <bool F8> struct EpiConv {
    static constexpr bool PERM = true, AFTER_DRAIN = false;
    static constexpr float KUP = -5.545177444479562f;
    bf16_t* ACT; const float* cw; const float* ssq; float* FB; float* HB; PG8_LAS float* halo;
    mutable int last_pm; PG8_LAS f32x4* rcache;
    PG8_LAS float* wbuf;
    static __device__ __forceinline__ f32x4 shr1(const f32x4 old, const f32x4 v) { f32x4 r;
#pragma unroll
        for (int e = 0; e < 4; ++e) { const float ov = old[e], vv = v[e];
            r[e] = __builtin_bit_cast(float, __builtin_amdgcn_update_dpp(__builtin_bit_cast(int, ov), __builtin_bit_cast(int, vv), 0x111, 0xf, 0xf, false)); }
        return r; }
    __device__ __forceinline__ void operator()(const f32x4 (&acc_in)[2][2][4][2], const Unit& u, int wr, int wc, int fr_, int fq_) const {
        int fr = fr_, fq = fq_; asm volatile("" : "+v"(fr), "+v"(fq));
        const int tok0 = u.pm * BM + wr * 64 + 4 * fr, lc = wc * 32 + 8 * fq;
        float rs[2][4];
        PG8_LAS f32x4* rc = rcache + 2 * ((wr * 4 + wc) * 64 + fq * 16 + fr);
        if (u.pm != last_pm) { rows_rstd(ssq, tok0, fq, rs, 1); last_pm = u.pm; rc[0] = (f32x4){rs[0][0], rs[0][1], rs[0][2], rs[0][3]}; rc[1] = (f32x4){rs[1][0], rs[1][1], rs[1][2], rs[1][3]}; }
        else { const f32x4 a_ = rc[0], b_ = rc[1]; rs[0][0] = a_[0]; rs[0][1] = a_[1]; rs[0][2] = a_[2]; rs[0][3] = a_[3]; rs[1][0] = b_[0]; rs[1][1] = b_[1]; rs[1][2] = b_[2]; rs[1][3] = b_[3]; }
#pragma unroll
        for (int ai = 0; ai < 2; ++ai)
#pragma unroll
            for (int m = 0; m < 4; ++m) rs[ai][m] *= (1.0f / 1024.0f);
        { const int t = (wr * 4 + wc) * 64 + fq * 16 + fr;
          if (t < 192) { const int tap = t >> 6, c4 = (t & 63) * 4; *(PG8_LAS f32x4*)(wbuf + tap * 256 + c4) = *(const f32x4*)(cw + tap * 5632 + (c4 >> 7) * 2816 + u.pn * HALF + (c4 & 127)) * ((c4 >> 7) ? 1.0f : -1.4426950408889634f)  ; } }
#pragma unroll
        for (int ai = 0; ai < 2; ++ai) { const int b = 2 * ai + wr;
            if (fr == 15) {
#pragma unroll
                for (int bj = 0; bj < 2; ++bj)
#pragma unroll
                    for (int n = 0; n < 2; ++n) { const float k8 = bj ? KUP : 1.0f; const f32x4 v2 = acc_in[ai][bj][2][n] * (rs[ai][2] * k8), v3 = acc_in[ai][bj][3][n] * (rs[ai][3] * k8);
                        *(PG8_LAS f32x4*)(halo + (b * 2 + 0) * 256 + bj * HALF + lc + 4 * n) = v2; *(PG8_LAS f32x4*)(halo + (b * 2 + 1) * 256 + bj * HALF + lc + 4 * n) = v3;
                        if (b == 3) { *(f32x4*)(HB + ((size_t)u.pm * 2 + 0) * 5632 + u.pn * BM + bj * HALF + lc + 4 * n) = v2; *(f32x4*)(HB + ((size_t)u.pm * 2 + 1) * 5632 + u.pn * BM + bj * HALF + lc + 4 * n) = v3; } } }
            if (b == 0 && fr == 0) {
#pragma unroll
                for (int bj = 0; bj < 2; ++bj)
#pragma unroll
                    for (int n = 0; n < 2; ++n) { const float k8 = bj ? KUP : 1.0f;
                        *(f32x4*)(FB + ((size_t)u.pm * 2 + 0) * 5632 + u.pn * BM + bj * HALF + lc + 4 * n) = acc_in[0][bj][0][n] * (rs[0][0] * k8);
                        *(f32x4*)(FB + ((size_t)u.pm * 2 + 1) * 5632 + u.pn * BM + bj * HALF + lc + 4 * n) = acc_in[0][bj][1][n] * (rs[0][1] * k8); } } }
        asm volatile("s_waitcnt lgkmcnt(0)\n\ts_barrier" ::: "memory");
#pragma unroll
        for (int ai = 0; ai < 2; ++ai) { const int b = 2 * ai + wr;
#pragma unroll
            for (int n = 0; n < 2; ++n) {
                __builtin_amdgcn_sched_barrier(0);
                const int ch = u.pn * HALF + lc + 4 * n;
                f32x4 y[2][4];
#pragma unroll
                for (int bj = 0; bj < 2; ++bj) {
                    f32x4 w0, w1, w2, p3, p2;
                    w0 = *(const PG8_LAS f32x4*)(wbuf + 0 * 256 + bj * HALF + lc + 4 * n); w1 = *(const PG8_LAS f32x4*)(wbuf + 1 * 256 + bj * HALF + lc + 4 * n); w2 = *(const PG8_LAS f32x4*)(wbuf + 2 * 256 + bj * HALF + lc + 4 * n);
                    if (b > 0) { p3 = *(const PG8_LAS f32x4*)(halo + ((b - 1) * 2 + 1) * 256 + bj * HALF + lc + 4 * n); p2 = *(const PG8_LAS f32x4*)(halo + ((b - 1) * 2 + 0) * 256 + bj * HALF + lc + 4 * n); }
                    else { p3 = (f32x4){0.f, 0.f, 0.f, 0.f}; p2 = p3; }
                    const float k8 = bj ? KUP : 1.0f;
                    const f32x4 a0 = acc_in[ai][bj][0][n] * (rs[ai][0] * k8), a1 = acc_in[ai][bj][1][n] * (rs[ai][1] * k8), a2 = acc_in[ai][bj][2][n] * (rs[ai][2] * k8), a3 = acc_in[ai][bj][3][n] * (rs[ai][3] * k8);
                    const f32x4 s3 = shr1(p3, a3), s2 = shr1(p2, a2);
                    y[bj][0] = w2 * a0 + w1 * s3 + w0 * s2; y[bj][1] = w2 * a1 + w1 * a0 + w0 * s3; y[bj][2] = w2 * a2 + w1 * a1 + w0 * a0; y[bj][3] = w2 * a3 + w1 * a2 + w0 * a1;
                }
#pragma unroll
                for (int m = 0; m < 4; ++m) { float o[4];
#pragma unroll
                    for (int e = 0; e < 4; ++e) { const float yg = y[0][m][e]; o[e] = yg * __builtin_amdgcn_rcpf(1.0f + __builtin_amdgcn_exp2f(yg)) * y[1][m][e]; }
                    *(unsigned*)((unsigned char*)ACT + (size_t)(tok0 + ai * HALF + m) * 2816 + ch) = pk4_fp8(o[0], o[1], o[2], o[3]); }
                asm volatile("" ::: "memory");
            }
        }
    }
};
}

__device__ __forceinline__ void tp_item(const float* W, int ldw, int k0, int srccol, float colscale, const float* gain, bf16* WT, int ldk, int drow0, LAS float* scr, int lane, bool f8 = false) {
    const float cm = (srccol >= 0) ? colscale : 0.f;
    const float* wp = W + (size_t)(k0 + (lane >> 5)) * ldw + (srccol >= 0 ? srccol : 0);
    float v[32];
#pragma unroll
    for (int i = 0; i < 32; ++i) v[i] = wp[(size_t)(2 * i) * ldw];
    if (gain) { const float* gp = gain + k0 + (lane >> 5); float gq[32];
#pragma unroll
        for (int i = 0; i < 32; ++i) gq[i] = gp[2 * i];
#pragma unroll
        for (int i = 0; i < 32; ++i) v[i] *= gq[i]; }
#pragma unroll
    for (int i = 0; i < 32; ++i) scr[(2 * i + (lane >> 5)) * 33 + (lane & 31)] = v[i] * cm;
    LDS_WAIT(); asm volatile("" ::: "memory");
    const int c = lane & 7;
#pragma unroll
    for (int j = 0; j < 4; ++j) { const int n = (lane >> 3) + 8 * j; const LAS float* s = scr + (8 * c) * 33 + n;
        if (f8) { typedef unsigned u32x2_t __attribute__((ext_vector_type(2))); u32x2_t q; q.x = pg8::pk4_fp8(s[0 * 33] * 256.f, s[1 * 33] * 256.f, s[2 * 33] * 256.f, s[3 * 33] * 256.f); q.y = pg8::pk4_fp8(s[4 * 33] * 256.f, s[5 * 33] * 256.f, s[6 * 33] * 256.f, s[7 * 33] * 256.f);
            *(u32x2_t*)((unsigned char*)WT + (size_t)(drow0 + n) * ldk + k0 + 8 * c) = q; continue; }
        v4u o; o.x = pk2(s[0 * 33], s[1 * 33]); o.y = pk2(s[2 * 33], s[3 * 33]); o.z = pk2(s[4 * 33], s[5 * 33]); o.w = pk2(s[6 * 33], s[7 * 33]);
        *(v4u*)(WT + (size_t)(drow0 + n) * ldk + k0 + 8 * c) = o; }
    LDS_WAIT(); asm volatile("" ::: "memory");
}
__device__ __forceinline__ int win_srccol_a(int n) {
    if (n < 512) return n;
    if (n < 640) return 512 + (n - 512);
    if (n < 664) return 1280 + (n - 640);
    if (n < 672) return 3352 + (n - 664);
    return -1;
}
__device__ __forceinline__ int win_srccol_b(int n) {
    if (n < 128) return 512 + 128 + n;
    if (n < 256) return 512 + 384 + (n - 128);
    if (n < 384) return 512 + 640 + (n - 256);
    if (n < 512) return 512 + 256 + (n - 384);
    if (n < 1024) return 1304 + (n - 512);
    if (n < 1536) return 1304 + 1024 + (n - 1024);
    if (n < 2048) return 2840 + (n - 1536);
    if (n < 2560) return 1304 + 512 + (n - 2048);
    if (n < 2688) return 512 + 512 + (n - 2560);
    return -1;
}

namespace nsa {
typedef short bf16x8 __attribute__((ext_vector_type(8)));
typedef float f32x16 __attribute__((ext_vector_type(16)));
typedef short s16x4 __attribute__((ext_vector_type(4)));
typedef float f32x2_t __attribute__((ext_vector_type(2))); typedef __bf16 bf16x2_t __attribute__((ext_vector_type(2)));
__device__ __forceinline__ unsigned cvtpk(float lo, float hi) { f32x2_t v = {lo, hi}; bf16x2_t b = __builtin_convertvector(v, bf16x2_t); return __builtin_bit_cast(unsigned, b); }
__device__ __forceinline__ int swz8(int r) { return (((r >> 1) & 1) << 2) | (((r >> 2) & 1) << 1) | ((r >> 3) & 1); }
__device__ __forceinline__ int crow(int r, int hi) { return (r & 3) + 8 * (r >> 2) + 4 * hi; }
__device__ __forceinline__ s16x4 vtr(const LAS unsigned char* p) { typedef short v4i16_t __attribute__((ext_vector_type(4))); return __builtin_bit_cast(s16x4, __builtin_amdgcn_ds_read_tr16_b64_v4i16((LAS v4i16_t*)p)); }
#define NSA_BAR() asm volatile("s_waitcnt lgkmcnt(0)\n\ts_barrier" ::: "memory")
__device__ __forceinline__ void glds16(const void* gsrc, unsigned lds_dst) { unsigned keep;
    asm volatile("s_mov_b32 %0, m0\n\ts_mov_b32 m0, %2\n\ts_nop 0\n\tglobal_load_lds_dwordx4 %1, off\n\ts_mov_b32 m0, %0" : "=&s"(keep) : "v"(gsrc), "s"(lds_dst) : "memory"); }
__device__ __forceinline__ float max2f(float a, float b) { float r; asm("v_max_f32_e32 %0, %1, %2" : "=v"(r) : "v"(a), "v"(b)); return r; }
__device__ __forceinline__ float max3f(float a, float b, float c) { float r; asm("v_max3_f32 %0, %1, %2, %3" : "=v"(r) : "v"(a), "v"(b), "v"(c)); return r; }
#define EXP2(x) __builtin_amdgcn_exp2f(x)

constexpr int IMP_P = 33, L_IMP = 0, L_SELM = 8448, L_WSC = 8704, L_K = 11264, L_V = L_K + 32768, L_OST = L_V + 32768, OST_PITCH = 1040, L_END = L_OST + 64 * OST_PITCH;
static_assert(L_END <= 158 * 1024, "nsa lds");

struct Lane {
    int tid, lane, w, r32, hi, g, th;
    int kbase; int ko[4];
    int vbase, xv;
    int soff;
    int goff;
    int goff8, k8a, k8b;
};
__device__ __forceinline__ void lane_init(Lane& L, int tid) {
    L.tid = tid; L.lane = tid & 63; L.w = __builtin_amdgcn_readfirstlane(tid >> 6); L.r32 = L.lane & 31; L.hi = L.lane >> 5; L.g = L.w >> 1; L.th = L.w & 1;
    const int sw = swz8(L.r32); L.kbase = L.r32 * 128;
#pragma unroll
    for (int d0 = 0; d0 < 4; ++d0) L.ko[d0] = ((2 * d0 + L.hi) ^ sw) << 4;
    const int kq = (L.lane & 15) >> 2, swl = (((kq >> 1) & 1) << 2) | (L.hi << 1), cl = 2 * ((L.lane >> 4) & 1) + ((L.lane & 3) >> 1);
    L.xv = cl ^ swl; L.vbase = (4 * L.hi + kq) * 128 + 8 * (L.lane & 1);
    const int row = tid >> 3, c = tid & 7; L.soff = row * 128 + ((c ^ swz8(row)) << 4); L.goff = row * 128 + ((c ^ swz8(row)) << 4);
    { const int key = 16 * (L.w & 3) + (L.lane >> 2), sw = (L.lane >> 4) & 3; L.goff8 = key * 64 + (((L.lane & 3) ^ sw) << 4);
      const int sw2 = (L.r32 >> 2) & 3; L.k8a = L.r32 * 64 + (((2 * L.hi) ^ sw2) << 4); L.k8b = L.r32 * 64 + (((2 * L.hi + 1) ^ sw2) << 4); }
}
__device__ __forceinline__ void tile_scores(const LAS unsigned char* kt, const Lane& L, const bf16x8 (&qf)[4], const f32x16& cinit, f32x16& p0, f32x16& p1) {
#pragma unroll
    for (int d0 = 0; d0 < 4; ++d0) {
        const bf16x8 a0 = *(const LAS bf16x8*)(kt + L.kbase + L.ko[d0]);
        const bf16x8 a1 = *(const LAS bf16x8*)(kt + L.kbase + 32 * 128 + L.ko[d0]);
        if (d0 == 0) { p0 = __builtin_amdgcn_mfma_f32_32x32x16_bf16(a0, qf[0], cinit, 0, 0, 0); p1 = __builtin_amdgcn_mfma_f32_32x32x16_bf16(a1, qf[0], cinit, 0, 0, 0); }
        else { p0 = __builtin_amdgcn_mfma_f32_32x32x16_bf16(a0, qf[d0], p0, 0, 0, 0); p1 = __builtin_amdgcn_mfma_f32_32x32x16_bf16(a1, qf[d0], p1, 0, 0, 0); }
    }
    asm volatile("s_nop 15\n\ts_nop 7" : "+v"(p0), "+v"(p1));
}
typedef int i32x8 __attribute__((ext_vector_type(8))); typedef int i32x4 __attribute__((ext_vector_type(4)));
__device__ __forceinline__ f32x16 mfma8(const i32x8& a, const i32x8& b, const f32x16& c, int sa, int sb) { f32x16 d;
    asm("v_mfma_scale_f32_32x32x64_f8f6f4 %0, %1, %2, %3, %4, %5 op_sel_hi:[0,0,0]" : "=&v"(d) : "v"(a), "v"(b), "v"(c), "v"(sa), "v"(sb)); return d; }
__device__ __forceinline__ void tile_scores8(const LAS unsigned char* kt, const Lane& L, const i32x8& q8, const f32x16& cinit, f32x16& p0, f32x16& p1, int sa, int sb) {
    const i32x4 a0 = *(const LAS i32x4*)(kt + L.k8a), a1 = *(const LAS i32x4*)(kt + L.k8b), b0 = *(const LAS i32x4*)(kt + 2048 + L.k8a), b1 = *(const LAS i32x4*)(kt + 2048 + L.k8b);
    const i32x8 ka = __builtin_shufflevector(a0, a1, 0, 1, 2, 3, 4, 5, 6, 7), kb = __builtin_shufflevector(b0, b1, 0, 1, 2, 3, 4, 5, 6, 7);
    p0 = mfma8(ka, q8, cinit, sa, sb); p1 = mfma8(kb, q8, cinit, sa, sb);
    asm volatile("s_nop 15\n\ts_nop 7" : "+v"(p0), "+v"(p1));
}
__device__ __forceinline__ void mfma8acc(f32x16& acc, const i32x8& a, const i32x8& b, int sa, int sb) {
    asm("v_mfma_scale_f32_32x32x64_f8f6f4 %0, %1, %2, %0, %3, %4 op_sel_hi:[0,0,0]" : "+v"(acc) : "v"(a), "v"(b), "v"(sa), "v"(sb)); }
__device__ __forceinline__ int cvt4f8(float a, float b, float c, float d) { int p = __builtin_amdgcn_cvt_pk_fp8_f32(a, b, 0, false); return __builtin_amdgcn_cvt_pk_fp8_f32(c, d, p, true); }
__device__ __forceinline__ void tile_pv8(const LAS unsigned char* vt, const Lane& L, const f32x16& p0, const f32x16& p1, f32x16 (&o)[2], f32x16& lacc, unsigned pmask, int sp, int sv) {
    i32x8 pa;
#pragma unroll
    for (int i = 0; i < 4; ++i) { pa[i] = cvt4f8(p0[4 * i], p0[4 * i + 1], p0[4 * i + 2], p0[4 * i + 3]) & (int)pmask; pa[4 + i] = cvt4f8(p1[4 * i], p1[4 * i + 1], p1[4 * i + 2], p1[4 * i + 3]) & (int)pmask; }
    const i32x4 a0 = *(const LAS i32x4*)(vt + L.k8a), a1 = *(const LAS i32x4*)(vt + L.k8b), b0 = *(const LAS i32x4*)(vt + 2048 + L.k8a), b1 = *(const LAS i32x4*)(vt + 2048 + L.k8b);
    const i32x8 v0 = __builtin_shufflevector(a0, a1, 0, 1, 2, 3, 4, 5, 6, 7), v1 = __builtin_shufflevector(b0, b1, 0, 1, 2, 3, 4, 5, 6, 7);
    mfma8acc(o[0], pa, v0, sp, sv); mfma8acc(o[1], pa, v1, sp, sv);
    i32x8 ones8;
#pragma unroll
    for (int i = 0; i < 8; ++i) ones8[i] = 0x38383838;
    mfma8acc(lacc, pa, ones8, sp, sp);
}
__device__ __forceinline__ void tile_pv(const LAS unsigned char* vt, const Lane& L, const f32x16& p0, const f32x16& p1, f32x16 (&o)[2], unsigned pmask = 0xffffffffu) {
#pragma unroll
    for (int kb = 0; kb < 2; ++kb)
#pragma unroll
        for (int s = 0; s < 2; ++s) {
            const f32x16& p = kb ? p1 : p0;
            typedef unsigned u32x4_t __attribute__((ext_vector_type(4)));
            u32x4_t pw; pw[0] = cvtpk(p[8 * s + 0], p[8 * s + 1]); pw[1] = cvtpk(p[8 * s + 2], p[8 * s + 3]); pw[2] = cvtpk(p[8 * s + 4], p[8 * s + 5]); pw[3] = cvtpk(p[8 * s + 6], p[8 * s + 7]);
            pw[0] &= pmask; pw[1] &= pmask; pw[2] &= pmask; pw[3] &= pmask;
            const bf16x8 pa = __builtin_bit_cast(bf16x8, pw);
#pragma unroll
            for (int dblk = 0; dblk < 2; ++dblk) {
                const LAS unsigned char* vb = vt + L.vbase + (kb * 32 + 16 * s) * 128;
                const s16x4 lo = vtr(vb + (((L.xv ^ (dblk << 2)) ^ 0) << 4));
                const s16x4 hi4 = vtr(vb + 8 * 128 + (((L.xv ^ (dblk << 2)) ^ 1) << 4));
                const bf16x8 vf = (bf16x8){lo[0], lo[1], lo[2], lo[3], hi4[0], hi4[1], hi4[2], hi4[3]};
                o[dblk] = __builtin_amdgcn_mfma_f32_32x32x16_bf16(pa, vf, o[dblk], 0, 0, 0);
            }
        }
}
__device__ __forceinline__ float rowmax32(const f32x16& p0, const f32x16& p1) {
    float a = max2f(p0[0], p1[0]), b = max2f(p0[1], p1[1]);
#pragma unroll
    for (int r = 2; r < 16; r += 2) { a = max3f(a, p0[r], p1[r]); b = max3f(b, p0[r + 1], p1[r + 1]); }
    a = max2f(a, b);
    return max2f(a, __shfl_xor(a, 32));
}
__device__ __forceinline__ void scale_rows(LAS float* wsc, const Lane& L, float sc, f32x16 (&o)[2], f32x16* extra = nullptr) {
    if (L.hi == 0) wsc[L.r32] = sc;
    asm volatile("s_waitcnt lgkmcnt(0)" ::: "memory");
#pragma unroll
    for (int i = 0; i < 4; ++i) { const f32x4 a = *(const LAS f32x4*)(wsc + 8 * i + 4 * L.hi);
#pragma unroll
        for (int d = 0; d < 2; ++d) { o[d][4 * i + 0] *= a[0]; o[d][4 * i + 1] *= a[1]; o[d][4 * i + 2] *= a[2]; o[d][4 * i + 3] *= a[3]; }
        if (extra) { (*extra)[4 * i + 0] *= a[0]; (*extra)[4 * i + 1] *= a[1]; (*extra)[4 * i + 2] *= a[2]; (*extra)[4 * i + 3] *= a[3]; } }
    asm volatile("s_waitcnt lgkmcnt(0)" ::: "memory");
}
template <bool ADD> __device__ __forceinline__ void ost_add(LAS bf16* ostw, const Lane& L, const f32x16 (&o)[2]) {
#pragma unroll
    for (int d = 0; d < 2; ++d)
#pragma unroll
        for (int r = 0; r < 16; ++r) { LAS bf16* p = ostw + crow(r, L.hi) * (OST_PITCH / 2) + d * 32 + L.r32; float v = o[d][r]; if (ADD) v += bf2f(*p); *p = (bf16)f2bf(v); }
}
template <int MODE, bool PRE = false> __device__ __forceinline__ void branch(const unsigned char* Kg8, const unsigned char* Vg8, int j0, int j1, int qb, int tq, unsigned selm, const i32x8& q8, LAS bf16* ostw, float gate,
                                                           LAS unsigned char* lds, const Lane& L) {
    float m = 0.f; bool seen = false; f32x16 o[2], negm, lacc;
#pragma unroll
    for (int r = 0; r < 16; ++r) { o[0][r] = 0.f; o[1][r] = 0.f; negm[r] = 0.f; lacc[r] = 0.f; }

    LAS float* wsc = (LAS float*)(lds + L_WSC) + L.w * 64;
    const int NT = j1 - j0 + 1;
    const unsigned char* kp = Kg8 + (size_t)j0 * 4096 + L.goff8; const unsigned char* vp = Vg8 + (size_t)j0 * 4096 + L.goff8;
    int sa8 = 0x7d7d7d7d, sb8 = 0x7a7a7a7a, sp8 = 0x7f7f7f7f; asm volatile("" : "+v"(sa8), "+v"(sb8), "+v"(sp8));
    const unsigned kdst0 = (unsigned)(size_t)(lds + L_K + (L.w & 3) * 1024), vdst0 = (unsigned)(size_t)(lds + L_V + (L.w & 3) * 1024);
#define NSA_DMA(t) do { if (L.w < 4) glds16(kp + (size_t)(t) * 4096, (unsigned)__builtin_amdgcn_readfirstlane((int)(kdst0 + ((t) & 7) * 4096))); \
                        else glds16(vp + (size_t)(t) * 4096, (unsigned)__builtin_amdgcn_readfirstlane((int)(vdst0 + ((t) & 7) * 4096))); } while (0)
    const int NP = (NT + 1) >> 1;
    if (!PRE) { NSA_BAR();
        NSA_DMA(0); if (NT > 1) NSA_DMA(1); if (NT > 2) NSA_DMA(2); if (NT > 3) NSA_DMA(3); }
    for (int ip = 0; ip < NP; ++ip) {
        const int ta = 2 * ip, ja = j0 + ta, jb2 = ja + 1; const bool hasb = ta + 1 < NT;
        if ((ip & 1) == 0) {
            asm volatile("s_waitcnt vmcnt(0)" ::: "memory");
            NSA_BAR();
            if (ta + 4 < NT) NSA_DMA(ta + 4);
            if (ta + 5 < NT) NSA_DMA(ta + 5);
            if (ta + 6 < NT) NSA_DMA(ta + 6);
            if (ta + 7 < NT) NSA_DMA(ta + 7);
        }
        const LAS unsigned char* kta = lds + L_K + (ta & 7) * 4096; const LAS unsigned char* vta = lds + L_V + (ta & 7) * 4096;
        const bool sela = (MODE == 1) ? (((selm >> ja) & 1u) != 0u) : true, selb = hasb && ((MODE == 1) ? (((selm >> jb2) & 1u) != 0u) : true);
        f32x16 pa0, pa1, pb0, pb1;
        tile_scores8(kta, L, q8, negm, pa0, pa1, sa8, sb8);
        if (hasb) tile_scores8(lds + L_K + ((ta + 1) & 7) * 4096, L, q8, negm, pb0, pb1, sa8, sb8);
        else {
#pragma unroll
            for (int r = 0; r < 16; ++r) { pb0[r] = -INFINITY; pb1[r] = -INFINITY; } }
#define NSA_MASKS(P0, P1, J) do { \
        if ((J) == qb) {                                             \
            int tqv = tq - 4 * L.hi; asm volatile("" : "+v"(tqv)); \
            _Pragma("unroll") for (int r = 0; r < 16; ++r) { const int kl = crow(r, 0); P0[r] = (kl > tqv) ? -INFINITY : P0[r]; P1[r] = (kl + 32 > tqv) ? -INFINITY : P1[r]; } } \
        if (MODE == 2 && (J) == qb - 8) {                            \
            int tqv = tq - 4 * L.hi; asm volatile("" : "+v"(tqv)); \
            _Pragma("unroll") for (int r = 0; r < 16; ++r) { const int kl = crow(r, 0); P0[r] = (kl <= tqv) ? -INFINITY : P0[r]; P1[r] = (kl + 32 <= tqv) ? -INFINITY : P1[r]; } } } while (0)
        NSA_MASKS(pa0, pa1, ja);
        if (hasb) NSA_MASKS(pb0, pb1, jb2);
#undef NSA_MASKS
        float rma = rowmax32(pa0, pa1), rmb = rowmax32(pb0, pb1);
        if (MODE == 1) { rma = sela ? rma : -INFINITY; rmb = selb ? rmb : -INFINITY; }
        const float rm = max2f(rma, rmb);
        const bool up = rm > 6.0f, dn = (rm < -64.0f) && (rm > -INFINITY) && !seen;
        if (__any(up || dn)) {
            const float dl = (up || dn) ? rm : 0.f;
            const float alpha = seen ? EXP2(-dl) : 1.0f;
#pragma unroll
            for (int r = 0; r < 16; ++r) { pa0[r] -= dl; pa1[r] -= dl; pb0[r] -= dl; pb1[r] -= dl; }
            m += dl; scale_rows(wsc, L, alpha, o, &lacc);
#pragma unroll
            for (int r = 0; r < 16; ++r) negm[r] = -m;
        }
        seen = seen || (rm > -INFINITY);
#pragma unroll
        for (int r = 0; r < 16; ++r) { pa0[r] = EXP2(pa0[r]); pa1[r] = EXP2(pa1[r]); }
        tile_pv8(vta, L, pa0, pa1, o, lacc, (MODE == 1 && !sela) ? 0u : 0xffffffffu, sp8, sa8);
        if (hasb) {
#pragma unroll
            for (int r = 0; r < 16; ++r) { pb0[r] = EXP2(pb0[r]); pb1[r] = EXP2(pb1[r]); }
            tile_pv8(lds + L_V + ((ta + 1) & 7) * 4096, L, pb0, pb1, o, lacc, (MODE == 1 && !selb) ? 0u : 0xffffffffu, sp8, sa8);
        }
    }
#undef NSA_DMA
    asm volatile("s_nop 15\n\ts_nop 7" : "+v"(o[0]), "+v"(o[1]), "+v"(lacc));
    scale_rows(wsc, L, gate, o);
#pragma unroll
    for (int r = 0; r < 16; ++r) { const float il = (lacc[r] > 0.f) ? __builtin_amdgcn_rcpf(lacc[r]) : 0.f; o[0][r] *= il; o[1][r] *= il; }
    ost_add<true>(ostw, L, o);
}

__device__ __forceinline__ void branch_prefetch(const unsigned char* Kg8, const unsigned char* Vg8, int j0, int NT, LAS unsigned char* lds, const Lane& L) {
    const unsigned char* kp = Kg8 + (size_t)j0 * 4096 + L.goff8; const unsigned char* vp = Vg8 + (size_t)j0 * 4096 + L.goff8;
    const unsigned kdst0 = (unsigned)(size_t)(lds + L_K + (L.w & 3) * 1024), vdst0 = (unsigned)(size_t)(lds + L_V + (L.w & 3) * 1024);
#pragma unroll
    for (int t = 0; t < 4; ++t) if (t < NT) { if (L.w < 4) glds16(kp + (size_t)t * 4096, (unsigned)__builtin_amdgcn_readfirstlane((int)(kdst0 + t * 4096)));
                                              else glds16(vp + (size_t)t * 4096, (unsigned)__builtin_amdgcn_readfirstlane((int)(vdst0 + t * 4096))); }
}
__device__ __forceinline__ void phase(const bf16* Qb, const bf16* KVb, const bf16* KC, const bf16* SMb, const bf16* OG, const bf16* Zb, bf16* MIX, LAS unsigned char* lds, int blk, int G, int tid_in) {
    Lane L; lane_init(L, tid_in);
    const int tid = L.tid, lane = L.lane, w = L.w, r32 = L.r32, hi = L.hi;
    LAS float* IMP = (LAS float*)(lds + L_IMP); LAS unsigned* SELM = (LAS unsigned*)(lds + L_SELM); LAS float* wsc = (LAS float*)(lds + L_WSC) + w * 64;
    for (int u = blk; u < 1024; u += G) {
        const int b = (u & 255) >> 3, s8 = u & 7, ui = u >> 8;
        const unsigned grp = (s8 == 0) ? 0x1f1e0501u : (s8 == 1) ? 0x1d1c0602u : (s8 == 2) ? 0x1b1a0703u : (s8 == 3) ? 0x19180904u : (s8 == 4) ? 0x17161500u : (s8 == 5) ? 0x14130b08u : (s8 == 6) ? 0x12110d0au : 0x100f0e0cu;
        const int qb = (int)((grp >> (8 * ui)) & 31u);
        const int tok0 = b * SEQ + 64 * qb, tq = 32 * L.th + r32, t = 64 * qb + tq;
        for (int hkv = 0; hkv < 2; ++hkv) {
            const int head = hkv * 4 + L.g;
            bf16x8 qf[4];
            { const bf16* qrow = Qb + (size_t)(tok0 + tq) * 512 + head * 64;
#pragma unroll
              for (int d0 = 0; d0 < 4; ++d0) qf[d0] = *(const bf16x8*)(qrow + 16 * d0 + 8 * hi); }
            const bf16* gp = SMb + (size_t)(tok0 + tq) * 32 + head * 3;
            const float gate0 = sigmf(bf2f(gp[0])), gate1 = sigmf(bf2f(gp[1])), gate2 = sigmf(bf2f(gp[2]));
            LAS bf16* ostw = (LAS bf16*)(lds + L_OST) + (32 * L.th) * (OST_PITCH / 2) + head * 64;
            v4u ckv[2][2];
            { const bf16* kcb = KC + ((size_t)((0 * 32 + b) * 2 + hkv) * 128) * 64; const bf16* vcb = KC + ((size_t)((1 * 32 + b) * 2 + hkv) * 128) * 64;
#pragma unroll
              for (int i = 0; i < 2; ++i) { const int e = tid + 512 * i; ckv[i][0] = *(const v4u*)(kcb + (size_t)e * 8); ckv[i][1] = *(const v4u*)(vcb + (size_t)e * 8); } }
            __builtin_amdgcn_sched_barrier(0);
            NSA_BAR();
#pragma unroll
            for (int i = 0; i < 2; ++i) { const int e = tid + 512 * i, row = e >> 3, c = e & 7, off = row * 128 + ((c ^ swz8(row)) << 4);
                *(LAS v4u*)(lds + L_K + off) = ckv[i][0]; *(LAS v4u*)(lds + L_V + off) = ckv[i][1]; }
            NSA_BAR();
            {
                f32x16 pa0, pa1, pb0, pb1, zinit;
                Lane Lc; { int tl = tid; asm volatile("" : "+v"(tl)); lane_init(Lc, tl); }
#pragma unroll
                for (int r = 0; r < 16; ++r) zinit[r] = 0.f;
                tile_scores(lds + L_K, Lc, qf, zinit, pa0, pa1); tile_scores(lds + L_K + 8192, Lc, qf, zinit, pb0, pb1);
                const int nmax = (t >= 31) ? ((t - 31) >> 4) : -1;
                int nmv = nmax - 4 * hi; asm volatile("" : "+v"(nmv));
#pragma unroll
                for (int r = 0; r < 16; ++r) { const int n = crow(r, 0);
                    pa0[r] = (n > nmv) ? -INFINITY : pa0[r]; pa1[r] = (n + 32 > nmv) ? -INFINITY : pa1[r]; pb0[r] = (n + 64 > nmv) ? -INFINITY : pb0[r]; pb1[r] = (n + 96 > nmv) ? -INFINITY : pb1[r]; }
                const float m = max2f(rowmax32(pa0, pa1), rowmax32(pb0, pb1)), ms = (m == -INFINITY) ? 0.f : m;
                float sum = 0.f;
#pragma unroll
                for (int r = 0; r < 16; ++r) { pa0[r] = EXP2(pa0[r] - ms); pa1[r] = EXP2(pa1[r] - ms); pb0[r] = EXP2(pb0[r] - ms); pb1[r] = EXP2(pb1[r] - ms); sum += (pa0[r] + pa1[r]) + (pb0[r] + pb1[r]); }
                sum += __shfl_xor(sum, 32);
                const float inv = (sum > 0.f) ? 1.0f / sum : 0.f;
#pragma unroll
                for (int r = 0; r < 16; ++r) { pa0[r] *= inv; pa1[r] *= inv; pb0[r] *= inv; pb1[r] *= inv; }
                { float own[16], carry[16];
#pragma unroll
                  for (int i = 0; i < 4; ++i) {
                      own[i] = (pa0[4 * i] + pa0[4 * i + 1]) + (pa0[4 * i + 2] + pa0[4 * i + 3]); carry[i] = pa0[4 * i + 3];
                      own[4 + i] = (pa1[4 * i] + pa1[4 * i + 1]) + (pa1[4 * i + 2] + pa1[4 * i + 3]); carry[4 + i] = pa1[4 * i + 3];
                      own[8 + i] = (pb0[4 * i] + pb0[4 * i + 1]) + (pb0[4 * i + 2] + pb0[4 * i + 3]); carry[8 + i] = pb0[4 * i + 3];
                      own[12 + i] = (pb1[4 * i] + pb1[4 * i + 1]) + (pb1[4 * i + 2] + pb1[4 * i + 3]); carry[12 + i] = pb1[4 * i + 3]; }
                  float recv[16];
#pragma unroll
                  for (int k = 0; k < 16; ++k) recv[k] = __shfl_xor(carry[k], 32);
                  LAS float* impw = (LAS float*)(lds + (w < 4 ? L_K + 16384 : L_V + 16384)) + (w & 3) * 1024 + r32;
#pragma unroll
                  for (int k = 0; k < 16; ++k) { const float add = hi ? recv[k] : (k > 0 ? recv[k - 1] : 0.f); impw[(2 * k + hi) * 32] = own[k] + add; } }
                f32x16 o[2];
#pragma unroll
                for (int r = 0; r < 16; ++r) { o[0][r] = 0.f; o[1][r] = 0.f; }
                tile_pv(lds + L_V, Lc, pa0, pa1, o); tile_pv(lds + L_V + 8192, Lc, pb0, pb1, o);
                scale_rows(wsc, L, gate0, o);
                ost_add<false>(ostw, L, o);
            }
            NSA_BAR();
            { const int sg = tid >> 6, tk = tid & 63, th2 = tk >> 5, q = tk & 31;
#pragma unroll
              for (int e = 0; e < 4; ++e) { float sacc = 0.f;
#pragma unroll
                  for (int g = 0; g < 4; ++g) { const int ww = 2 * g + th2; sacc += *(const LAS float*)(lds + (ww < 4 ? L_K + 16384 : L_V + 16384) + ((ww & 3) * 1024 + (4 * sg + e) * 32 + q) * 4); }
                  IMP[tk * IMP_P + 4 * sg + e] = sacc; } }
            NSA_BAR();
            const unsigned char* ks = (const unsigned char*)KVb + 2 * KV_PIECE_BYTES + ((size_t)(b * 2 + hkv) * 2048) * 64; const unsigned char* vs = (const unsigned char*)KVb + 3 * KV_PIECE_BYTES + ((size_t)(b * 2 + hkv) * 2048) * 64;
            branch_prefetch(ks, vs, 0, qb + 1, lds, L);
            {
                const int tk = tid >> 3, s8 = tid & 7;
                unsigned mask;
                if (qb <= 7) mask = (2u << qb) - 1u;
                else {
                    mask = 1u | (1u << qb) | (1u << (qb - 1));
                    unsigned key[4];
#pragma unroll
                    for (int e = 0; e < 4; ++e) { const int j = 4 * s8 + e; const unsigned bits = __float_as_uint(IMP[tk * IMP_P + j]); key[e] = (j >= 1 && j <= qb - 2) ? ((bits & ~31u) | (unsigned)(31 - j)) : 0u; }
#pragma unroll
                    for (int rsel = 0; rsel < 5; ++rsel) {
                        unsigned b0 = key[0] > key[1] ? key[0] : key[1], b1 = key[2] > key[3] ? key[2] : key[3]; unsigned best = b0 > b1 ? b0 : b1;
                        unsigned o;
                        o = (unsigned)__builtin_amdgcn_mov_dpp((int)best, 0x141, 0xf, 0xf, true); best = o > best ? o : best;
                        o = (unsigned)__builtin_amdgcn_mov_dpp((int)best, 0xB1, 0xf, 0xf, true); best = o > best ? o : best;
                        o = (unsigned)__builtin_amdgcn_mov_dpp((int)best, 0x4E, 0xf, 0xf, true); best = o > best ? o : best;
                        if (best != 0u) { mask |= 1u << (31 - (int)(best & 31u));
#pragma unroll
                            for (int e = 0; e < 4; ++e) key[e] = (key[e] == best) ? 0u : key[e]; } }
                }
                if (s8 == 0) SELM[tk] = mask;
            }
            NSA_BAR();
            const unsigned selm = SELM[tq];
            i32x8 q8;
#pragma unroll
            for (int d0 = 0; d0 < 4; ++d0) { typedef unsigned u4_t __attribute__((ext_vector_type(4))); const u4_t qq = __builtin_bit_cast(u4_t, qf[d0]);
                q8[2 * d0] = (int)pg8::pk4_fp8(bflo(qq.x) * 32.f, bfhi(qq.x) * 32.f, bflo(qq.y) * 32.f, bfhi(qq.y) * 32.f); q8[2 * d0 + 1] = (int)pg8::pk4_fp8(bflo(qq.z) * 32.f, bfhi(qq.z) * 32.f, bflo(qq.w) * 32.f, bfhi(qq.w) * 32.f); }
            branch<1, true>(ks, vs, 0, qb, qb, tq, selm, q8, ostw, gate1, lds, L);
            { const unsigned char* kw = (const unsigned char*)KVb + 4 * KV_PIECE_BYTES + ((size_t)(b * 2 + hkv) * 2048) * 64; const unsigned char* vw = (const unsigned char*)KVb + 5 * KV_PIECE_BYTES + ((size_t)(b * 2 + hkv) * 2048) * 64;
              branch<2>(kw, vw, qb >= 8 ? qb - 8 : 0, qb, qb, tq, 0u, q8, ostw, gate2, lds, L); }
        }
        NSA_BAR();
        { const int tk = tid >> 3, seg = tid & 7; const size_t tok = (size_t)tok0 + tk;
          const v4u* op = (const v4u*)(OG + tok * 512 + seg * 64); const v4u* zp = (const v4u*)(Zb + tok * 512 + seg * 64);
          v4u ov[8], zv[8];
#pragma unroll
          for (int i = 0; i < 8; ++i) { ov[i] = op[i]; zv[i] = zp[i]; }
          { const LAS unsigned char* src = lds + L_OST + tk * OST_PITCH + seg * 128;
            v4u v[8]; float ss = 0.f;
#pragma unroll
            for (int i = 0; i < 8; ++i) { v[i] = *(const LAS v4u*)(src + 16 * i);
                ss += bflo(v[i].x) * bflo(v[i].x) + bfhi(v[i].x) * bfhi(v[i].x) + bflo(v[i].y) * bflo(v[i].y) + bfhi(v[i].y) * bfhi(v[i].y)
                    + bflo(v[i].z) * bflo(v[i].z) + bfhi(v[i].z) * bfhi(v[i].z) + bflo(v[i].w) * bflo(v[i].w) + bfhi(v[i].w) * bfhi(v[i].w); }
            ss += __shfl_xor(ss, 1); ss += __shfl_xor(ss, 2); ss += __shfl_xor(ss, 4);
            const float rstd = 1.0f / sqrtf(ss * (1.0f / 512.0f) + EPS);
            bf16* dst = MIX + tok * 1024 + seg * 64;
#pragma unroll
            for (int i = 0; i < 8; ++i) { v4u o; o.x = pk2(bflo(v[i].x) * rstd, bfhi(v[i].x) * rstd); o.y = pk2(bflo(v[i].y) * rstd, bfhi(v[i].y) * rstd);
                o.z = pk2(bflo(v[i].z) * rstd, bfhi(v[i].z) * rstd); o.w = pk2(bflo(v[i].w) * rstd, bfhi(v[i].w) * rstd); *(v4u*)(dst + 8 * i) = o; } }
          { float ss = 0.f;
#pragma unroll
            for (int i = 0; i < 8; ++i) { const v4u a = ov[i];
                ss += bflo(a.x) * bflo(a.x) + bfhi(a.x) * bfhi(a.x) + bflo(a.y) * bflo(a.y) + bfhi(a.y) * bfhi(a.y) + bflo(a.z) * bflo(a.z) + bfhi(a.z) * bfhi(a.z) + bflo(a.w) * bflo(a.w) + bfhi(a.w) * bfhi(a.w); }
            ss += __shfl_xor(ss, 1);
            const float rstd = 1.0f / sqrtf(ss * (1.0f / 128.0f) + EPS);
            bf16* dst = MIX + tok * 1024 + 512 + seg * 64;
#pragma unroll
            for (int i = 0; i < 8; ++i) { const v4u a = ov[i], z = zv[i]; v4u o;
                o.x = pk2(bflo(a.x) * rstd * siluf(bflo(z.x)), bfhi(a.x) * rstd * siluf(bfhi(z.x))); o.y = pk2(bflo(a.y) * rstd * siluf(bflo(z.y)), bfhi(a.y) * rstd * siluf(bfhi(z.y)));
                o.z = pk2(bflo(a.z) * rstd * siluf(bflo(z.z)), bfhi(a.z) * rstd * siluf(bfhi(z.z))); o.w = pk2(bflo(a.w) * rstd * siluf(bflo(z.w)), bfhi(a.w) * rstd * siluf(bfhi(z.w)));
                *(v4u*)(dst + 8 * i) = o; } } }
    }
}
}

namespace gdn {
typedef short bf16x8 __attribute__((ext_vector_type(8)));
typedef float f32x16 __attribute__((ext_vector_type(16)));
using nsa::crow; using nsa::cvtpk;
typedef unsigned u32x2 __attribute__((ext_vector_type(2)));
#define GDN_BAR() asm volatile("s_waitcnt lgkmcnt(0)\n\ts_barrier" ::: "memory")
constexpr int IP = 272;
constexpr int AOP = 144, XTP = 144;
constexpr int L_SC = 0, L_AT = 3072, L_QI = L_AT + 64 * 64 * 4, L_KI = L_QI + 64 * IP, L_VI = L_KI + 64 * IP, L_AO = L_VI + 64 * IP, L_XT = L_AO + 64 * AOP, L_TI = L_XT + 256 * XTP, L_RT = L_TI + 2048, L_PRE_END = L_RT + 256 * 32;
static_assert(L_PRE_END <= 158 * 1024, "gdn pre lds");
constexpr int ITEM_BYTES = 73728, O_W = 0, O_UT = 16384, O_QG = 32768, O_KGT = 49152, O_ATT = 65536;

__device__ __forceinline__ void pre_phase(const bf16* Gb, const bf16* SMb, const float* convw, const float* a_log, const float* dt_bias, unsigned char* GP, float* GL,
                                          LAS unsigned char* lds, int blk, int G, int tid) {
    const int lane = tid & 63, w = __builtin_amdgcn_readfirstlane(tid >> 6), r32 = lane & 31, hi = lane >> 5;
    LAS float* SC = (LAS float*)(lds + L_SC); LAS float* AT = (LAS float*)(lds + L_AT);
    int par = 0;
    const bool deal = (G == 256); const int nit = deal ? (blk < 128 ? 15 : 17) : (NB * GH * 32 - blk + G - 1) / G;
    for (int ii = 0; ii < nit; ++ii, par ^= 1) {
        const int item = (deal && ii == 16) ? 15 * 256 + (blk - 128) : blk + ii * G;
        const int bh = item >> 5, c = item & 31, b = bh >> 2, h = bh & 3, tok0 = b * SEQ + 64 * c;
        unsigned char* out = GP + (size_t)item * ITEM_BYTES;
        GDN_BAR();
        if (w == 7) {
            const size_t tok = (size_t)tok0 + lane;
            const float bb = bf2f(SMb[tok * 32 + 24 + h]), aa = bf2f(SMb[tok * 32 + 28 + h]);
            const float g = -__expf(a_log[h]) * softplusf(aa + dt_bias[h]);
            float gc = g;
#pragma unroll
            for (int o = 1; o < 64; o <<= 1) { const float t = __shfl_up(gc, o); if (lane >= o) gc += t; }
            const float glast = __shfl(gc, 63);
            SC[lane] = gc; SC[64 + lane] = sigmf(bb); SC[128 + lane] = __expf(gc); SC[192 + lane] = __expf(glast - gc);
            if (lane == 0) GL[item] = __expf(glast);
        }
#pragma unroll
        for (int si = 0; si < 2; ++si) {
            if (si == 1 && w >= 4) break;
            const int sidx = tid + 512 * si, cg = sidx % 48, t4 = sidx / 48, which = cg >> 4, col = which * 512 + h * 128 + 8 * (cg & 15);
            f32x4 wt[4][2];
#pragma unroll
            for (int j = 0; j < 4; ++j) { wt[j][0] = *(const f32x4*)(convw + j * 1536 + col); wt[j][1] = *(const f32x4*)(convw + j * 1536 + col + 4); }
            v4u rw[7];
#pragma unroll
            for (int rr = 0; rr < 7; ++rr) { const int sq = 64 * c + 4 * t4 - 3 + rr; rw[rr] = (sq >= 0) ? *(const v4u*)(Gb + (size_t)(tok0 + 4 * t4 - 3 + rr) * 1536 + col) : (v4u){0u, 0u, 0u, 0u}; }
#pragma unroll
            for (int t = 0; t < 4; ++t) {
                float y[8];
#pragma unroll
                for (int e = 0; e < 8; ++e) y[e] = 0.f;
#pragma unroll
                for (int j = 0; j < 4; ++j) { const v4u x = rw[t + j];
                    y[0] += wt[j][0][0] * bflo(x.x); y[1] += wt[j][0][1] * bfhi(x.x); y[2] += wt[j][0][2] * bflo(x.y); y[3] += wt[j][0][3] * bfhi(x.y);
                    y[4] += wt[j][1][0] * bflo(x.z); y[5] += wt[j][1][1] * bfhi(x.z); y[6] += wt[j][1][2] * bflo(x.w); y[7] += wt[j][1][3] * bfhi(x.w); }
#pragma unroll
                for (int e = 0; e < 8; ++e) { y[e] = siluf(y[e]); }
                v4u o; o.x = pk2(y[0], y[1]); o.y = pk2(y[2], y[3]); o.z = pk2(y[4], y[5]); o.w = pk2(y[6], y[7]);
                const int tk = 4 * t4 + t;
                *(LAS v4u*)(lds + L_QI + which * (64 * IP) + tk * IP + 16 * (cg & 15)) = o;
                if (which < 2) {
                    float tt = (y[0] * y[0] + y[1] * y[1]) + (y[2] * y[2] + y[3] * y[3]) + (y[4] * y[4] + y[5] * y[5]) + (y[6] * y[6] + y[7] * y[7]);
                    tt += __builtin_bit_cast(float, __builtin_amdgcn_mov_dpp(__builtin_bit_cast(int, tt), 0x128, 0xf, 0xf, true));
                    tt += __builtin_bit_cast(float, __builtin_amdgcn_mov_dpp(__builtin_bit_cast(int, tt), 0x124, 0xf, 0xf, true));
                    tt += __builtin_bit_cast(float, __builtin_amdgcn_mov_dpp(__builtin_bit_cast(int, tt), 0x122, 0xf, 0xf, true));
                    tt += __builtin_bit_cast(float, __builtin_amdgcn_mov_dpp(__builtin_bit_cast(int, tt), 0x121, 0xf, 0xf, true));
                    if ((cg & 15) == 0) SC[384 + which * 64 + tk] = tt; }
            }
        }
        GDN_BAR();
        float pft = 0.f;
        if (ii + 1 < nit && tid < 434) {
            const int itn = (deal && ii + 1 == 16) ? 15 * 256 + (blk - 128) : blk + (ii + 1) * G;
            const int bhn = itn >> 5, cn = itn & 31, bn = bhn >> 2, hn = bhn & 3, rown = tid / 6, segn = (tid % 6) >> 1, halfn = tid & 1;
            const int sn = 64 * cn - 3 + rown;
            if (tid >= 402) pft = *(const float*)(SMb + (size_t)(bn * SEQ + 64 * cn + 2 * (tid - 402)) * 32);
            else if (sn >= 0) pft = *(const float*)(Gb + (size_t)(bn * SEQ + sn) * 1536 + segn * 512 + hn * 128 + halfn * 64);
        }
        if (tid < 128) { const int which = tid >> 6, tk = tid & 63; SC[256 + tid] = (1.0f / sqrtf(SC[384 + which * 64 + tk] + EPS)) * (which == 0 ? 0.08838834764831845f : 1.0f); }
        GDN_BAR();
        if (w < 4) {
            const int ti = w >> 1, tj = w & 1;
            if (tj <= ti) {
                f32x16 acc;
#pragma unroll
                for (int r = 0; r < 16; ++r) acc[r] = 0.f;
#pragma unroll
                for (int ks = 0; ks < 8; ++ks) {
                    const bf16x8 a = *(const LAS bf16x8*)(lds + L_KI + (32 * tj + r32) * IP + 32 * ks + 16 * hi);
                    const bf16x8 bq = *(const LAS bf16x8*)(lds + L_KI + (32 * ti + r32) * IP + 32 * ks + 16 * hi);
                    acc = __builtin_amdgcn_mfma_f32_32x32x16_bf16(a, bq, acc, 0, 0, 0);
                }
                const int i = 32 * ti + r32; const float gi = SC[i], bi = SC[64 + i] * SC[320 + i]; int iv = i - 4 * hi; asm volatile("" : "+v"(iv));
#pragma unroll
                for (int g4 = 0; g4 < 4; ++g4) { f32x4 v;
#pragma unroll
                    for (int e = 0; e < 4; ++e) { const int j0 = 32 * tj + 8 * g4 + e, j = j0 + 4 * hi; v[e] = (j0 < iv) ? bi * SC[320 + j] * acc[4 * g4 + e] * __expf(gi - SC[j]) : 0.f; }
                    *(LAS f32x4*)(AT + i * 64 + 32 * tj + 8 * g4 + 4 * hi) = v;
                    const bool dg = (2 * tj + (g4 >> 1)) == (i >> 4);
                    u32x2 pkd; pkd.x = dg ? 0u : cvtpk(v[0], v[1]); pkd.y = dg ? 0u : cvtpk(v[2], v[3]);
                    *(LAS u32x2*)(lds + L_AO + i * AOP + 2 * (32 * tj + 8 * g4 + 4 * hi)) = pkd; }
            } else {
                const int i = r32;
#pragma unroll
                for (int g4 = 0; g4 < 4; ++g4) *(LAS u32x2*)(lds + L_AO + i * AOP + 2 * (32 + 8 * g4 + 4 * hi)) = (u32x2){0u, 0u};
            }
        } else {
            const int ti = (w - 4) >> 1, tj = (w - 4) & 1;
            f32x16 acc;
#pragma unroll
            for (int r = 0; r < 16; ++r) acc[r] = 0.f;
            if (tj <= ti) {
#pragma unroll
                for (int ks = 0; ks < 8; ++ks) {
                    const bf16x8 a = *(const LAS bf16x8*)(lds + L_KI + (32 * tj + r32) * IP + 32 * ks + 16 * hi);
                    const bf16x8 bq = *(const LAS bf16x8*)(lds + L_QI + (32 * ti + r32) * IP + 32 * ks + 16 * hi);
                    acc = __builtin_amdgcn_mfma_f32_32x32x16_bf16(a, bq, acc, 0, 0, 0);
                }
            }
            const int i = 32 * ti + r32; const float gi = SC[i], qi = SC[256 + i]; int iv = i - 4 * hi; asm volatile("" : "+v"(iv));
            bf16* att = (bf16*)(out + O_ATT);
#pragma unroll
            for (int g4 = 0; g4 < 4; ++g4) { float v[4];
#pragma unroll
                for (int e = 0; e < 4; ++e) { const int j0 = 32 * tj + 8 * g4 + e, j = j0 + 4 * hi; v[e] = (j0 <= iv) ? qi * SC[320 + j] * acc[4 * g4 + e] * __expf(gi - SC[j]) : 0.f; }
                u32x2 pkd; pkd.x = cvtpk(v[0], v[1]); pkd.y = cvtpk(v[2], v[3]);
                *(u32x2*)(att + i * 64 + 32 * tj + 8 * g4 + 4 * hi) = pkd; }
        }
        GDN_BAR();
        if (w == 7) {
            const int d = lane >> 4, c = lane & 15; float x[16];
#pragma unroll
            for (int r = 0; r < 16; ++r) { float v = (r == c) ? 1.0f : 0.0f;
#pragma unroll
                for (int q = 0; q < (r + 3) / 4; ++q) { const f32x4 a = *(const LAS f32x4*)(AT + (16 * d + r) * 64 + 16 * d + 4 * q);
#pragma unroll
                    for (int e = 0; e < 4; ++e) if (4 * q + e < r) v -= a[e] * x[4 * q + e]; }
                x[r] = v; *(LAS bf16*)(lds + L_TI + ((d * 16 + r) * 16 + c) * 2) = (bf16)f2bf(v);
                if ((r & 3) == 3) asm volatile("" ::: "memory"); }
        } else {
            bf16* qg = (bf16*)(out + O_QG); bf16* kgt = (bf16*)(out + O_KGT);
#pragma unroll
            for (int i = 0; i < 3; ++i) { const int v = tid + 448 * i; if (v < 1024) { const int row = v >> 4, ch = v & 15; const float e = SC[128 + row] * SC[256 + row];
                const v4u a = *(const LAS v4u*)(lds + L_QI + row * IP + 16 * ch);
                v4u o; o.x = pk2(bflo(a.x) * e, bfhi(a.x) * e); o.y = pk2(bflo(a.y) * e, bfhi(a.y) * e); o.z = pk2(bflo(a.z) * e, bfhi(a.z) * e); o.w = pk2(bflo(a.w) * e, bfhi(a.w) * e);
                *(v4u*)(qg + row * 128 + 8 * ch) = o; } }
#pragma unroll
            for (int i = 0; i < 3; ++i) { const int u = tid + 448 * i; if (u < 1024) { const int dk = u & 127, qq = u >> 7; float v[8];
#pragma unroll
                for (int e = 0; e < 8; ++e) { const int cc = 8 * qq + e; v[e] = bf2f(*(const LAS bf16*)(lds + L_KI + cc * IP + 2 * dk)) * (SC[192 + cc] * SC[320 + cc]); }
                v4u o; o.x = pk2(v[0], v[1]); o.y = pk2(v[2], v[3]); o.z = pk2(v[4], v[5]); o.w = pk2(v[6], v[7]);
                *(v4u*)(kgt + dk * 64 + 8 * qq) = o; } }
        }
        { const int l16 = lane & 15, lq = lane >> 4;
#pragma unroll
          for (int t2 = 0; t2 < 2; ++t2)
#pragma unroll
              for (int q = 0; q < 2; ++q) *(LAS v4u*)(lds + L_XT + (16 * (2 * w + t2) + l16) * XTP + 64 * q + 16 * lq) = (v4u){0u, 0u, 0u, 0u}; }
        GDN_BAR();
        {
            typedef float f32x4_t __attribute__((ext_vector_type(4)));
            const int l16 = lane & 15, lq = lane >> 4; const bool isu = w < 4;
            const bf16x8 zero8 = (bf16x8){0, 0, 0, 0, 0, 0, 0, 0};
#pragma unroll 1
            for (int I = 0; I < 4; ++I) {
                const bf16x8 tfr = (lq < 2) ? *(const LAS bf16x8*)(lds + L_TI + ((I * 16 + l16) * 16 + 8 * lq) * 2) : zero8;
#pragma unroll
                for (int t2 = 0; t2 < 2; ++t2) {
                    const int cidx = 16 * (2 * w + t2) + l16;
                    f32x4_t acc = {0.f, 0.f, 0.f, 0.f};
                    if (I > 0) {
#pragma unroll
                        for (int ks = 0; ks < 2; ++ks) { const bf16x8 a = *(const LAS bf16x8*)(lds + L_AO + (16 * I + l16) * AOP + 64 * ks + 16 * lq);
                            const bf16x8 bq = *(const LAS bf16x8*)(lds + L_XT + cidx * XTP + 64 * ks + 16 * lq);
                            acc = __builtin_amdgcn_mfma_f32_16x16x32_bf16(a, bq, acc, 0, 0, 0); } }
                    const LAS unsigned char* rsrc = lds + (isu ? L_VI + 2 * cidx : L_KI + 2 * (cidx - 128));
                    float rr[4];
#pragma unroll
                    for (int e = 0; e < 4; ++e) { const int i = 16 * I + 4 * lq + e; const float sc = isu ? SC[64 + i] : SC[64 + i] * SC[128 + i] * SC[320 + i]; rr[e] = bf2f(*(const LAS bf16*)(rsrc + i * IP)) * sc - acc[e]; }
                    u32x2 pkd; pkd.x = cvtpk(rr[0], rr[1]); pkd.y = cvtpk(rr[2], rr[3]);
                    *(LAS u32x2*)(lds + L_RT + cidx * 32 + 8 * lq) = pkd;
                    asm volatile("s_waitcnt lgkmcnt(0)" ::: "memory");
                    const bf16x8 rfr = (lq < 2) ? *(const LAS bf16x8*)(lds + L_RT + cidx * 32 + 16 * lq) : zero8;
                    f32x4_t xa = {0.f, 0.f, 0.f, 0.f};
                    xa = __builtin_amdgcn_mfma_f32_16x16x32_bf16(tfr, rfr, xa, 0, 0, 0);
                    u32x2 xo; xo.x = cvtpk(xa[0], xa[1]); xo.y = cvtpk(xa[2], xa[3]);
                    *(LAS u32x2*)(lds + L_XT + cidx * XTP + 2 * (16 * I + 4 * lq)) = xo;
                    if (isu) *(u32x2*)((bf16*)(out + O_UT) + cidx * 64 + 16 * I + 4 * lq) = xo;
                    else { bf16* wo = (bf16*)(out + O_W) + (size_t)(16 * I + 4 * lq) * 128 + (cidx - 128);
                        wo[0] = (bf16)(xo.x & 0xffffu); wo[128] = (bf16)(xo.x >> 16); wo[256] = (bf16)(xo.y & 0xffffu); wo[384] = (bf16)(xo.y >> 16); }
                }
                asm volatile("s_waitcnt lgkmcnt(0)" ::: "memory");
            }
        }
        asm volatile("" :: "v"(pft));
    }
}

constexpr int SP = 272, VP = 144;
constexpr int L_ST = 0, L_VN = 64 * SP, L_DEC = L_VN + 64 * VP, L_RING = L_DEC + 128, SLOT = 65536;
constexpr int R_W = 0, R_QG = 16384, R_KGT = 32768, R_ATT = 49152, R_UT = 57344;
static_assert(L_RING % 16 == 0 && L_RING + 2 * SLOT <= 158 * 1024, "scan lds");
__device__ __forceinline__ void scan_phase(const unsigned char* GP, const float* GL, bf16* OG, LAS unsigned char* lds, int blk, int G, int tid) {
    const int lane = tid & 63, w = __builtin_amdgcn_readfirstlane(tid >> 6), r32 = lane & 31, hi = lane >> 5;
    const int kbk = w & 3, vb = w >> 2, cblk = w & 1, vblk = (w >> 1) & 1, role = w >> 2;
    for (int it = blk; it < NB * GH * 2; it += G) {
        const int bh = it & 127, half = it >> 7, b = bh >> 2, h = bh & 3;
        int sa[10], sb[6];
        if (w < 4) {
#pragma unroll
            for (int i = 0; i < 10; ++i) { const int j = w + 4 * i;
                const int row4 = 4 * (j & 15) + (lane >> 4), cp4 = lane & 15, row8 = 8 * (j - 32) + (lane >> 3), cp8 = lane & 7;
                sa[i] = (j < 32) ? (j < 16 ? O_W : O_QG) + row4 * 256 + ((cp4 ^ (row4 & 15)) << 4) : O_UT + half * 8192 + row8 * 128 + ((cp8 ^ nsa::swz8(row8)) << 4); }
#pragma unroll
            for (int i = 0; i < 6; ++i) { const int j = w + 4 * i, pl = j < 16 ? j : j - 16, row = 8 * pl + (lane >> 3), cp = lane & 7;
                sb[i] = (j < 16 ? O_KGT : O_ATT) + row * 128 + ((cp ^ nsa::swz8(row)) << 4); }
        }
        const unsigned ringb = (unsigned)(size_t)(lds + L_RING);
#define SCAN_DMA_A(n) do { if (w < 4) { const unsigned char* gsrc_ = GP + (size_t)(bh * 32 + (n)) * ITEM_BYTES; const unsigned d_ = ringb + ((n) & 1) * SLOT; \
        _Pragma("unroll") for (int i_ = 0; i_ < 10; ++i_) { const int j_ = w + 4 * i_, p_ = j_ < 32 ? j_ : j_ + 24; nsa::glds16(gsrc_ + sa[i_], (unsigned)__builtin_amdgcn_readfirstlane((int)(d_ + p_ * 1024))); } } } while (0)
#define SCAN_DMA_B(n) do { if (w < 4) { const unsigned char* gsrc_ = GP + (size_t)(bh * 32 + (n)) * ITEM_BYTES; const unsigned d_ = ringb + ((n) & 1) * SLOT; \
        _Pragma("unroll") for (int i_ = 0; i_ < 6; ++i_) { const int j_ = w + 4 * i_; nsa::glds16(gsrc_ + sb[i_], (unsigned)__builtin_amdgcn_readfirstlane((int)(d_ + (32 + j_) * 1024))); } } } while (0)
#define SCAN_WAIT(cond) do { if (w < 4) { if (cond) asm volatile("s_waitcnt vmcnt(16)" ::: "memory"); else asm volatile("s_waitcnt vmcnt(0)" ::: "memory"); } } while (0)
        GDN_BAR();
        SCAN_DMA_A(0); SCAN_DMA_B(0); SCAN_DMA_A(1); SCAN_DMA_B(1);
        for (int i = tid; i < (64 * SP) / 16; i += 512) *(LAS v4u*)(lds + L_ST + 16 * i) = (v4u){0u, 0u, 0u, 0u};
        if (tid < 32) *(LAS float*)(lds + L_DEC + 4 * tid) = GL[bh * 32 + tid];
        f32x16 sacc;
#pragma unroll
        for (int r = 0; r < 16; ++r) sacc[r] = 0.f;
        SCAN_WAIT(true);
        GDN_BAR();
        for (int n = 0; n < 32; ++n) {
            const LAS unsigned char* sl = lds + L_RING + (n & 1) * SLOT;
            f32x16 acc, acc1;
#pragma unroll
            for (int r = 0; r < 16; ++r) { acc[r] = 0.f; acc1[r] = 0.f; }
            u32x2 uq[4];
            if (role == 0) { const int urow = 32 * vblk + r32; const LAS unsigned char* ub = sl + R_UT + urow * 128 + 8 * hi; const int usw = nsa::swz8(urow);
#pragma unroll
                for (int g4 = 0; g4 < 4; ++g4) uq[g4] = *(const LAS u32x2*)(ub + (((4 * cblk + g4) ^ usw) << 4)); }
            { const int arow = 32 * cblk + r32; const LAS unsigned char* ab = sl + (role ? R_QG : R_W) + arow * 256;
#pragma unroll
              for (int ks = 0; ks < 8; ks += 2) { const bf16x8 a = *(const LAS bf16x8*)(ab + (((2 * ks + hi) ^ (arow & 15)) << 4));
                  const bf16x8 bfr = *(const LAS bf16x8*)(lds + L_ST + (32 * vblk + r32) * SP + 32 * ks + 16 * hi);
                  const bf16x8 a2 = *(const LAS bf16x8*)(ab + (((2 * ks + 2 + hi) ^ (arow & 15)) << 4));
                  const bf16x8 bfr2 = *(const LAS bf16x8*)(lds + L_ST + (32 * vblk + r32) * SP + 32 * ks + 32 + 16 * hi);
                  acc = __builtin_amdgcn_mfma_f32_32x32x16_bf16(a, bfr, acc, 0, 0, 0); acc1 = __builtin_amdgcn_mfma_f32_32x32x16_bf16(a2, bfr2, acc1, 0, 0, 0); }
#pragma unroll
              for (int r = 0; r < 16; ++r) acc[r] += acc1[r]; }
            if (role == 0) {
#pragma unroll
                for (int g4 = 0; g4 < 4; ++g4) { const u32x2 uu = uq[g4];
                    const float v0 = bflo(uu.x) - acc[4 * g4], v1 = bfhi(uu.x) - acc[4 * g4 + 1], v2 = bflo(uu.y) - acc[4 * g4 + 2], v3 = bfhi(uu.y) - acc[4 * g4 + 3];
                    u32x2 pkd; pkd.x = cvtpk(v0, v1); pkd.y = cvtpk(v2, v3);
                    *(LAS u32x2*)(lds + L_VN + (32 * vblk + r32) * VP + 2 * (32 * cblk + 8 * g4 + 4 * hi)) = pkd; }
            }
            SCAN_WAIT(n + 1 < 32);
            GDN_BAR();
            if (n + 2 < 32) SCAN_DMA_A(n + 2);
            if (role == 1) {
                const int arow = 32 * cblk + r32; const LAS unsigned char* ab = sl + R_ATT + arow * 128; const int asw = nsa::swz8(arow);
#pragma unroll
                for (int ks = 0; ks < 4; ++ks) { const bf16x8 a = *(const LAS bf16x8*)(ab + (((2 * ks + hi) ^ asw) << 4));
                    const bf16x8 bfr = *(const LAS bf16x8*)(lds + L_VN + (32 * vblk + r32) * VP + 32 * ks + 16 * hi);
                    acc = __builtin_amdgcn_mfma_f32_32x32x16_bf16(a, bfr, acc, 0, 0, 0); }
                bf16* orow = OG + (size_t)(b * SEQ + 64 * n + 32 * cblk) * 512 + h * 128 + half * 64 + 32 * vblk + r32;
#pragma unroll
                for (int r = 0; r < 16; ++r) orow[(size_t)crow(r, hi) * 512] = (bf16)f2bf(acc[r]);
            }
            {
              const float dec = *(const LAS float*)(lds + L_DEC + 4 * n);
              const int krow = 32 * kbk + r32; const LAS unsigned char* kb2 = sl + R_KGT + krow * 128; const int ksw = nsa::swz8(krow);
#pragma unroll
              for (int r = 0; r < 16; ++r) sacc[r] *= dec;
#pragma unroll
              for (int ks = 0; ks < 4; ++ks) { const bf16x8 a = *(const LAS bf16x8*)(kb2 + (((2 * ks + hi) ^ ksw) << 4));
                  const bf16x8 bfr = *(const LAS bf16x8*)(lds + L_VN + (32 * vb + r32) * VP + 32 * ks + 16 * hi);
                  sacc = __builtin_amdgcn_mfma_f32_32x32x16_bf16(a, bfr, sacc, 0, 0, 0); }
#pragma unroll
              for (int g4 = 0; g4 < 4; ++g4) { u32x2 pkd; pkd.x = cvtpk(sacc[4 * g4], sacc[4 * g4 + 1]); pkd.y = cvtpk(sacc[4 * g4 + 2], sacc[4 * g4 + 3]);
                  *(LAS u32x2*)(lds + L_ST + (32 * vb + r32) * SP + 2 * (32 * kbk + 8 * g4 + 4 * hi)) = pkd; } }
            SCAN_WAIT(n + 2 < 32);
            GDN_BAR();
            if (n + 2 < 32) SCAN_DMA_B(n + 2);
        }
#undef SCAN_DMA_A
#undef SCAN_DMA_B
#undef SCAN_WAIT
    }
}
}

namespace cmp {
typedef short bf16x8 __attribute__((ext_vector_type(8)));
typedef float f32x16 __attribute__((ext_vector_type(16)));
struct OneUnit {
    int c;
    __device__ bool next(int i, pg8::Unit& u) const { if (i > 0 || c >= 128) return false; const int idx = c & 63; u.pm = idx >> 1; u.pn = idx & 1; return true; }
    __device__ __forceinline__ void a_ready(const pg8::Unit&) const {}
    __device__ __forceinline__ void done(const pg8::Unit&) const {}
};
constexpr int HP = 528;
__device__ __forceinline__ void post(const bf16* P, const float* b1p, const bf16* w2T, bf16* KC, LAS unsigned char* lds, int blk, int tid) {
    if (blk >= 128) return;
    const int lane = tid & 63, w = __builtin_amdgcn_readfirstlane(tid >> 6), r32 = lane & 31, hi = lane >> 5;
    const int kv = blk >> 6, bh = blk & 63;
    const bf16* Pb = P + (size_t)kv * 8192 * 512 + (size_t)bh * 128 * 512;
    LAS float* bias = (LAS float*)(lds + 128 * HP);
    asm volatile("s_waitcnt lgkmcnt(0)\n\ts_barrier" ::: "memory");
    if (tid < 256) { const float* pp = b1p + kv * 2048 + tid; float sacc = 0.f;
#pragma unroll
        for (int k = 0; k < 8; ++k) sacc += pp[k * 256];
        bias[tid] = sacc; }
    asm volatile("s_waitcnt lgkmcnt(0)\n\ts_barrier" ::: "memory");
    for (int v = tid; v < 4096; v += 512) {
        const int n = v >> 5, c8 = (v & 31) * 8; v4u o = (v4u){0u, 0u, 0u, 0u};
        if (n < 127) { const v4u a = *(const v4u*)(Pb + (size_t)n * 512 + c8), b = *(const v4u*)(Pb + (size_t)(n + 1) * 512 + 256 + c8);
            const f32x4 b0 = *(const LAS f32x4*)(bias + c8), b1 = *(const LAS f32x4*)(bias + c8 + 4);
            o.x = pk2(gelu_tanh(bflo(a.x) + bflo(b.x) + b0[0]), gelu_tanh(bfhi(a.x) + bfhi(b.x) + b0[1])); o.y = pk2(gelu_tanh(bflo(a.y) + bflo(b.y) + b0[2]), gelu_tanh(bfhi(a.y) + bfhi(b.y) + b0[3]));
            o.z = pk2(gelu_tanh(bflo(a.z) + bflo(b.z) + b1[0]), gelu_tanh(bfhi(a.z) + bfhi(b.z) + b1[1])); o.w = pk2(gelu_tanh(bflo(a.w) + bflo(b.w) + b1[2]), gelu_tanh(bfhi(a.w) + bfhi(b.w) + b1[3])); }
        *(LAS v4u*)(lds + n * HP + 2 * c8) = o;
    }
    asm volatile("s_waitcnt lgkmcnt(0)\n\ts_barrier" ::: "memory");
    const int rb = w & 3, cb = w >> 2;
    f32x16 acc;
#pragma unroll
    for (int r = 0; r < 16; ++r) acc[r] = 0.f;
    const bf16* wrow = w2T + (size_t)kv * 64 * 256 + (32 * cb + r32) * 256 + 8 * hi;
#pragma unroll
    for (int ks = 0; ks < 16; ++ks) { const bf16x8 a = *(const LAS bf16x8*)(lds + (32 * rb + r32) * HP + 32 * ks + 16 * hi); const bf16x8 bq = *(const bf16x8*)(wrow + 16 * ks);
        acc = __builtin_amdgcn_mfma_f32_32x32x16_bf16(a, bq, acc, 0, 0, 0); }
    bf16* dst = KC + ((size_t)(kv * 64 + bh) * 128 + 32 * rb) * 64 + 32 * cb + r32;
#pragma unroll
    for (int r = 0; r < 16; ++r) dst[(size_t)nsa::crow(r, hi) * 64] = (bf16)f2bf(acc[r]);
    asm volatile("s_waitcnt lgkmcnt(0)\n\ts_barrier" ::: "memory");
}
}

__device__ __forceinline__ void rms_row_to_bf16(const float* xrow, bf16* orow, unsigned char* o8row, int lane) {
    const f32x4* xr = (const f32x4*)xrow + lane;
    f32x4 v[4]; float s = 0.f;
#pragma unroll
    for (int j = 0; j < 4; ++j) { v[j] = xr[64 * j]; s += (v[j].x * v[j].x + v[j].y * v[j].y) + (v[j].z * v[j].z + v[j].w * v[j].w); }
    const float rstd = 1.0f / sqrtf(wave_sum(s) * (1.f / DM) + EPS);
    unsigned long long* o8 = (unsigned long long*)orow + lane;
#pragma unroll
    for (int j = 0; j < 4; ++j) o8[64 * j] = (unsigned long long)pk2(v[j].x * rstd, v[j].y * rstd) | ((unsigned long long)pk2(v[j].z * rstd, v[j].w * rstd) << 32);
    const float r4 = 4.0f * rstd; unsigned* q4 = (unsigned*)o8row + lane;
#pragma unroll
    for (int j = 0; j < 4; ++j) q4[64 * j] = pg8::pk4_fp8(v[j].x * r4, v[j].y * r4, v[j].z * r4, v[j].w * r4);
}
__device__ __forceinline__ void rms_rows2_to_bf16(const float* xrow0, const float* xrow1, bf16* orow0, bf16* orow1, unsigned char* p8row0, unsigned char* p8row1, int lane) {
    const f32x4* xr0 = (const f32x4*)xrow0 + lane; const f32x4* xr1 = (const f32x4*)xrow1 + lane;
    f32x4 v0[4], v1[4]; float s0 = 0.f, s1 = 0.f;
#pragma unroll
    for (int j = 0; j < 4; ++j) { v0[j] = xr0[64 * j]; v1[j] = xr1[64 * j]; }
#pragma unroll
    for (int j = 0; j < 4; ++j) { s0 += (v0[j].x * v0[j].x + v0[j].y * v0[j].y) + (v0[j].z * v0[j].z + v0[j].w * v0[j].w); s1 += (v1[j].x * v1[j].x + v1[j].y * v1[j].y) + (v1[j].z * v1[j].z + v1[j].w * v1[j].w); }
#pragma unroll
    for (int o = 1; o < 64; o <<= 1) { s0 += __shfl_xor(s0, o); s1 += __shfl_xor(s1, o); }
    const float r0 = 1.0f / sqrtf(s0 * (1.f / DM) + EPS), r1 = 1.0f / sqrtf(s1 * (1.f / DM) + EPS);
    unsigned long long* o0 = (unsigned long long*)orow0 + lane; unsigned long long* o1 = (unsigned long long*)orow1 + lane;
#pragma unroll
    for (int j = 0; j < 4; ++j) { o0[64 * j] = (unsigned long long)pk2(v0[j].x * r0, v0[j].y * r0) | ((unsigned long long)pk2(v0[j].z * r0, v0[j].w * r0) << 32);
        o1[64 * j] = (unsigned long long)pk2(v1[j].x * r1, v1[j].y * r1) | ((unsigned long long)pk2(v1[j].z * r1, v1[j].w * r1) << 32); }
    const float r40 = 4.0f * r0, r41 = 4.0f * r1; unsigned* q0 = (unsigned*)p8row0 + lane; unsigned* q1 = (unsigned*)p8row1 + lane;
#pragma unroll
    for (int j = 0; j < 4; ++j) { q0[64 * j] = pg8::pk4_fp8(v0[j].x * r40, v0[j].y * r40, v0[j].z * r40, v0[j].w * r40); q1[64 * j] = pg8::pk4_fp8(v1[j].x * r41, v1[j].y * r41, v1[j].z * r41, v1[j].w * r41); }
}
__device__ __forceinline__ void final_norm_row(const bf16* xrow, float* orow, const float* g, float rstd, int lane) {
    const unsigned long long* xr = (const unsigned long long*)xrow + lane; f32x4* o = (f32x4*)orow + lane; const f32x4* gr = (const f32x4*)g + lane;
#pragma unroll
    for (int j = 0; j < 4; ++j) { const unsigned long long v = xr[64 * j]; const unsigned lo = (unsigned)v, hi = (unsigned)(v >> 32);
        o[64 * j] = (f32x4){bflo(lo), bfhi(lo), bflo(hi), bfhi(hi)} * rstd * gr[64 * j]; }
}

__device__ __forceinline__ void ffn_seam_fixup(const float* FBp, const float* HBp, const float* cw, bf16* ACT, int gtid, int gthreads) {
    const int total = 256 * 2 * (FF / 4);
    for (int i = gtid; i < total; i += gthreads) {
        const int pm = i / (2 * (FF / 4)), rem = i % (2 * (FF / 4)), r = rem / (FF / 4), c4 = (rem % (FF / 4)) * 4;
        if ((pm & 7) == 0) continue;
        const int col = (c4 >> 7) * 256 + (c4 & 127);
        const float* cur = FBp + ((size_t)pm * 2 + r) * FF2 + col;
        const float* p1 = (r == 0) ? HBp + ((size_t)(pm - 1) * 2 + 1) * FF2 + col : FBp + ((size_t)pm * 2 + 0) * FF2 + col;
        const float* p2 = (r == 0) ? HBp + ((size_t)(pm - 1) * 2 + 0) * FF2 + col : HBp + ((size_t)(pm - 1) * 2 + 1) * FF2 + col;
        const f32x4 g0 = *(const f32x4*)cur, g1 = *(const f32x4*)p1, g2 = *(const f32x4*)p2, u0 = *(const f32x4*)(cur + 128), u1 = *(const f32x4*)(p1 + 128), u2 = *(const f32x4*)(p2 + 128);
        const f32x4 wg0 = *(const f32x4*)(cw + c4), wg1 = *(const f32x4*)(cw + FF2 + c4), wg2 = *(const f32x4*)(cw + 2 * FF2 + c4);
        const f32x4 wu0 = *(const f32x4*)(cw + FF + c4), wu1 = *(const f32x4*)(cw + FF2 + FF + c4), wu2 = *(const f32x4*)(cw + 2 * FF2 + FF + c4);
        float o[4];
#pragma unroll
        for (int e = 0; e < 4; ++e) { const float yg = wg2[e] * g0[e] + wg1[e] * g1[e] + wg0[e] * g2[e], yu = wu2[e] * u0[e] + wu1[e] * u1[e] + wu0[e] * u2[e]; o[e] = siluf(yg) * yu * -1.4426950408889634f; }
        *(unsigned*)((unsigned char*)ACT + (size_t)(pm * 256 + r) * FF + c4) = pg8::pk4_fp8(o[0], o[1], o[2], o[3]);
    }
}

struct Args { const float* in[22]; float* out; unsigned char* ws; };

__device__ __forceinline__ const unsigned char __attribute__((address_space(4)))* karg_base() {
    const unsigned char __attribute__((address_space(4)))* p = (const unsigned char __attribute__((address_space(4)))*)__builtin_amdgcn_kernarg_segment_ptr();
    asm volatile("" : "+s"(p)); return p; }
#define KIN(i) (*(const float* const __attribute__((address_space(4)))*)(karg_base() + 8 * (i)))
#define KOUT() (*(float* const __attribute__((address_space(4)))*)(karg_base() + 176))
#define KWS() (*(unsigned char* const __attribute__((address_space(4)))*)(karg_base() + 184))
#define LANE_ID() ((int)__builtin_amdgcn_mbcnt_hi(~0u, __builtin_amdgcn_mbcnt_lo(~0u, 0u)))
#define GRID_BAR() xcd_barrier(bar, wv == 0 && LANE_ID() == 0)
#define PHASE_IDS() int wvo_ = wv; asm volatile("" : "+s"(wvo_)); int tid = wvo_ * 64 + LANE_ID(); asm volatile("" : "+v"(tid)); const int lane = tid & 63, wave = wv, gw = blk * NWAVES + wave, NGW = G * NWAVES; (void)lane; (void)gw; (void)NGW
template <int l> __device__ __forceinline__ void layer_body(unsigned char* ws, LAS unsigned char* lds, const XcdBarrier& bar, int G, int blk, const int wv) {
#define WSP(off) ((bf16*)(ws + (off)))
    unsigned char* wl = ws + WS_WTS + (size_t)l * WTS_LAYER;
    float* SSQ = (float*)(ws + WS_SSQ);
    if (l == 0) { PHASE_IDS(); const float* xcur = KIN(0);
      int m = gw;
      for (; m + NGW < MTOK; m += 2 * NGW) rms_rows2_to_bf16(xcur + (size_t)m * DM, xcur + (size_t)(m + NGW) * DM, WSP(WS_H) + (size_t)m * DM, WSP(WS_H) + (size_t)(m + NGW) * DM, ws + WS_H8B + (size_t)m * DM, ws + WS_H8B + (size_t)(m + NGW) * DM, lane);
      if (m < MTOK) rms_row_to_bf16(xcur + (size_t)m * DM, WSP(WS_H) + (size_t)m * DM, ws + WS_H8B + (size_t)m * DM, lane);
      GRID_BAR(); }
    { pg8::Gemm g{WSP(WS_H), (const bf16*)(wl + WO_IN), MTOK, INA, DM}; pg8::StaticOrder S; S.init(MTOK, INA, G, blk);
      pg8::EpiIn<(l > 0), 0> E{WSP(WS_Q), WSP(WS_KV), WSP(WS_G), WSP(WS_Z), WSP(WS_SM), SSQ + (size_t)(l > 0 ? 2 * l - 1 : 0) * MTOK * 16, -1, (LAS f32x4*)(lds + 136 * 1024), 1.0f};
      pg8::gemm_phase<pg8::EpiIn<(l > 0), 0>, pg8::StaticOrder, true, true>(lds, g, S, E, wv); }
    { pg8::Gemm g{(const bf16*)(ws + WS_H8B), (const bf16*)(wl + WO_IN + (size_t)INA * DM * 2), MTOK, INB, DM}; pg8::StaticOrder S; S.init(MTOK, INB, G, blk);
      pg8::EpiIn<(l > 0), 1> E{WSP(WS_Q), WSP(WS_KV), WSP(WS_G), WSP(WS_Z), WSP(WS_SM), SSQ + (size_t)(l > 0 ? 2 * l - 1 : 0) * MTOK * 16, -1, (LAS f32x4*)(lds + 136 * 1024), 1.0f / 1024.0f};
      pg8::gemm_phase<pg8::EpiIn<(l > 0), 1>, pg8::StaticOrder, true, true, true>(lds, g, S, E, wv); }
    GRID_BAR();
    { const int kvsel = (blk >> 6) & 1;
      pg8::Gemm g{WSP(WS_KV) + (size_t)kvsel * (NB * HKV * SEQ * DH), (const bf16*)(wl + (kvsel ? WO_W1V : WO_W1K)), 8192, 512, 1024}; cmp::OneUnit S{blk};
      pg8::EpiPlain<false> E{WSP(WS_P) + (size_t)kvsel * 8192 * 512, 512, nullptr};
      pg8::gemm_phase<pg8::EpiPlain<false>, cmp::OneUnit, true, true>(lds, g, S, E, wv); }
    { PHASE_IDS();
      gdn::pre_phase(WSP(WS_G), WSP(WS_SM), KIN(12) + l * 4 * 1536, KIN(13) + l * GH, KIN(14) + l * GH, ws + WS_GP, (float*)(ws + WS_GL), lds, blk, G, tid); }
    GRID_BAR();
    { PHASE_IDS(); cmp::post(WSP(WS_P), (const float*)(ws + WS_CTL) + CW_B1P + l * 2 * 2048, (const bf16*)(wl + WO_MISC), WSP(WS_KC), lds, blk, tid);
      gdn::scan_phase(ws + WS_GP, (const float*)(ws + WS_GL), WSP(WS_G), lds, blk, G, tid); }
    GRID_BAR();
    { PHASE_IDS(); nsa::phase(WSP(WS_Q), WSP(WS_KV), WSP(WS_KC), WSP(WS_SM), WSP(WS_G), WSP(WS_Z), WSP(WS_MIX), lds, blk, G, tid); }
    GRID_BAR();
    { pg8::Gemm g{WSP(WS_MIX), (const bf16*)(wl + WO_OUT), MTOK, DM, DM}; pg8::StaticOrder S; S.init(MTOK, DM, G, blk);
      pg8::EpiResSq<(l == 0), true> E{(l == 0) ? (const void*)KIN(0) : (const void*)WSP(WS_H), WSP(WS_H), SSQ + (size_t)(2 * l) * MTOK * 16, ws + WS_H8, 1.0f};
      pg8::gemm_phase<pg8::EpiResSq<(l == 0), true>, pg8::StaticOrder, true, true>(lds, g, S, E, wv); }
    GRID_BAR();
    { pg8::Gemm g{(const bf16*)(ws + WS_H8), (const bf16*)(wl + WO_UP), MTOK, FF2, DM}; pg8::StaticOrder S; S.init(MTOK, FF2, G, blk);
      pg8::EpiConv<true> E{WSP(WS_ACT), KIN(19) + l * 3 * FF2, SSQ + (size_t)(2 * l) * MTOK * 16, (float*)(ws + WS_FB), (float*)(ws + WS_HB), (LAS float*)(lds + 128 * 1024), -1, (LAS f32x4*)(lds + 136 * 1024), (LAS float*)(lds + 152 * 1024)};
      pg8::gemm_phase<pg8::EpiConv<true>, pg8::StaticOrder, true, true, true, true>(lds, g, S, E, wv); }
    GRID_BAR();
    { PHASE_IDS(); ffn_seam_fixup((const float*)(ws + WS_FB), (const float*)(ws + WS_HB), KIN(19) + l * 3 * FF2, WSP(WS_ACT), blk * (NWAVES * 64) + tid, G * NWAVES * 64); }
    GRID_BAR();
    { pg8::Gemm g{WSP(WS_ACT), (const bf16*)(wl + WO_DN), MTOK, DM, FF}; pg8::StaticOrder S; S.init(MTOK, DM, G, blk);
      pg8::EpiResSq<false, (l + 1 < NLAYER)> E{(const void*)WSP(WS_H), WSP(WS_H), SSQ + (size_t)(2 * l + 1) * MTOK * 16, ws + WS_H8B, 1.0f / 2048.0f};
      pg8::gemm_phase<pg8::EpiResSq<false, (l + 1 < NLAYER)>, pg8::StaticOrder, true, true, true>(lds, g, S, E, wv); }
    GRID_BAR();
}

__global__ void __launch_bounds__(NWAVES * 64, 2) fwd(Args a) {
    extern __shared__ __attribute__((aligned(16))) unsigned char lds_raw[];
    LAS unsigned char* lds = (LAS unsigned char*)lds_raw;
    const int G = gridDim.x, blk = blockIdx.x;
    const int wv = __builtin_amdgcn_readfirstlane(threadIdx.x >> 6);
    unsigned char* ws = KWS();
    volatile LAS unsigned* MISC = (volatile LAS unsigned*)(lds + MISC_OFF);
    for (int u = wv * 64 + LANE_ID(); u < (LDS_BYTES - MISC_OFF) / 4; u += NWAVES * 64) MISC[u] = 0u;
    __syncthreads();
    XcdBarrier bar = xcd_barrier_post((unsigned*)(ws + WS_CTL) + CW_BAR, MISC + 8, wv == 0 && LANE_ID() == 0);

    {
        PHASE_IDS();
        LAS float* gv = (LAS float*)(lds + 128 * 1024);
        for (int i = tid; i < NLAYER * 1024; i += NWAVES * 64) { const int l = i >> 10, k = i & 1023; gv[i] = (k < 512) ? KIN(11)[l * 512 + k] : KIN(15)[l * 128 + ((k - 512) & 127)]; }
        __syncthreads();
        if (blk < 32) {
            const int combo = blk >> 3, ksl = blk & 7, ll = combo >> 1, kv = combo & 1, c = tid & 255, kh = tid >> 8;
            const float* w1 = (kv ? KIN(8) : KIN(5)) + (size_t)ll * 2048 * 256; const float* pos = (kv ? KIN(4) : KIN(3)) + ll * 2048;
            float acc = (ksl == 0 && kh == 0) ? ((kv ? KIN(9) : KIN(6))[ll * 256 + c]) : 0.f;
            const int kbeg = ksl * 256 + kh * 128;
#pragma unroll 8
            for (int k = kbeg; k < kbeg + 128; ++k) acc += pos[k] * w1[(size_t)k * 256 + c];
            LAS float* red = (LAS float*)(lds + 136 * 1024);
            if (kh == 1) red[c] = acc;
            __syncthreads();
            if (kh == 0) ((float*)(ws + WS_CTL) + CW_B1P)[(combo * 8 + ksl) * 256 + c] = acc + red[c];
        }
        LAS float* scr = (LAS float*)(lds + wave * 16384);
        constexpr int I_INA = 16 * (INA / 32), I_INB = 16 * (INB / 32), I_IN = I_INA + I_INB, I_OUT = 16 * 32, I_UP = 16 * (FF2 / 32), I_DN = (FF / 64) * 32, I_W1 = 2 * 2 * 128, I_W2 = 2 * 8, I_L = I_IN + I_OUT + I_UP + I_DN + I_W1 + I_W2;
        for (int it = gw; it < NLAYER * I_L; it += NGW) {
            const int l = it / I_L; int r = it % I_L; unsigned char* wl = ws + WS_WTS + (size_t)l * WTS_LAYER;
            if (r < I_INA) { const int nbk = INA / 32, kb = r / nbk, nb = r % nbk, n = nb * 32 + (lane & 31);
                tp_item(KIN(2) + (size_t)l * DM * INW, INW, kb * 64, win_srccol_a(n), n < 512 ? QSCALE : 1.0f, KIN(1) + l * DM, (bf16*)(wl + WO_IN), DM, nb * 32, scr, lane); continue; }
            if (r < I_IN) { const int r2 = r - I_INA, nbk = INB / 32, kb = r2 / nbk, nb = r2 % nbk, n = nb * 32 + (lane & 31);
                tp_item(KIN(2) + (size_t)l * DM * INW, INW, kb * 64, win_srccol_b(n), 1.0f, KIN(1) + l * DM, (bf16*)(wl + WO_IN + (size_t)INA * DM * 2), DM, nb * 32, scr, lane, true); continue; }
            r -= I_IN;
            if (r < I_OUT) { const int kb = r / 32, nb = r % 32;
                tp_item(KIN(16) + (size_t)l * DM * DM, DM, kb * 64, nb * 32 + (lane & 31), 1.0f, (const float*)(gv + l * 1024), (bf16*)(wl + WO_OUT), DM, nb * 32, scr, lane); continue; }
            r -= I_OUT;
            if (r < I_UP) { const int nbk = FF2 / 32, kb = r / nbk, nb = r % nbk;
                const int n = nb * 32 + (lane & 31), pnn = n >> 8, rr = n & 255;
                tp_item(KIN(18) + (size_t)l * DM * FF2, FF2, kb * 64, rr < 128 ? 128 * pnn + rr : FF + 128 * pnn + (rr - 128), 1.0f, KIN(17) + l * DM, (bf16*)(wl + WO_UP), DM, nb * 32, scr, lane, true); continue; }
            r -= I_UP;
            if (r < I_DN) { const int kb = r / 32, nb = r % 32;
                tp_item(KIN(20) + (size_t)l * FF * DM, DM, kb * 64, nb * 32 + (lane & 31), 1.0f, nullptr, (bf16*)(wl + WO_DN), FF, nb * 32, scr, lane, true); continue; }
            r -= I_DN;
            if (r < I_W1) { const int kv = r >> 8, hf = (r >> 7) & 1, kb = (r & 127) >> 3, nb = r & 7;
                tp_item((kv ? KIN(8) : KIN(5)) + (size_t)l * 2048 * 256 + (size_t)hf * 1024 * 256, 256, kb * 64, nb * 32 + (lane & 31), 1.0f, nullptr, (bf16*)(wl + (kv ? WO_W1V : WO_W1K)), 1024, hf * 256 + nb * 32, scr, lane); continue; }
            r -= I_W1;
            { const int kv = r >> 3, kb = (r & 7) >> 1, nb = r & 1;
                tp_item((kv ? KIN(10) : KIN(7)) + (size_t)l * 256 * 64, 64, kb * 64, nb * 32 + (lane & 31), 1.0f, nullptr, (bf16*)(wl + WO_MISC) + kv * 64 * 256, 256, nb * 32, scr, lane); }
        }
    }

    layer_body<0>(ws, lds, bar, G, blk, wv);
    layer_body<1>(ws, lds, bar, G, blk, wv);
    { PHASE_IDS(); float* xo = KOUT(); const float* gf = KIN(21);
      const float* sq = (const float*)(ws + WS_SSQ) + (size_t)3 * MTOK * 16;
      f32x4 gq[4];
#pragma unroll
      for (int j = 0; j < 4; ++j) gq[j] = ((const f32x4*)gf + lane)[64 * j];
      int m = gw;
      for (; m + NGW < MTOK; m += 2 * NGW) {
          const unsigned long long* x0 = (const unsigned long long*)((const bf16*)(ws + WS_H) + (size_t)m * DM) + lane; const unsigned long long* x1 = (const unsigned long long*)((const bf16*)(ws + WS_H) + (size_t)(m + NGW) * DM) + lane;
          unsigned long long a0[4], a1[4];
#pragma unroll
          for (int j = 0; j < 4; ++j) { a0[j] = x0[64 * j]; a1[j] = x1[64 * j]; }
          const float r0 = pg8::row_rstd(sq, m), r1 = pg8::row_rstd(sq, m + NGW);
          f32x4* o0 = (f32x4*)(xo + (size_t)m * DM) + lane; f32x4* o1 = (f32x4*)(xo + (size_t)(m + NGW) * DM) + lane;
#pragma unroll
          for (int j = 0; j < 4; ++j) { const unsigned l0 = (unsigned)a0[j], h0 = (unsigned)(a0[j] >> 32), l1 = (unsigned)a1[j], h1 = (unsigned)(a1[j] >> 32);
              o0[64 * j] = (f32x4){bflo(l0), bfhi(l0), bflo(h0), bfhi(h0)} * r0 * gq[j]; o1[64 * j] = (f32x4){bflo(l1), bfhi(l1), bflo(h1), bfhi(h1)} * r1 * gq[j]; } }
      if (m < MTOK) final_norm_row((const bf16*)(ws + WS_H) + (size_t)m * DM, xo + (size_t)m * DM, gf, pg8::row_rstd(sq, m), lane); }
}

extern "C" void kernel_launch(void* const* d_in, const int* in_sizes, int n_in, void* d_out, int out_size, void* d_ws, size_t ws_size, hipStream_t stream) {
    static int grid = 0;
    if (grid == 0) {
        if (n_in != 22 || in_sizes[0] != MTOK * DM || out_size != MTOK * DM || ws_size < WS_END) {
            fprintf(stderr, "kernel_launch: unexpected shapes (n_in %d, in0 %d, out %d, ws %zu, need %zu); nothing launched\n", n_in, n_in > 0 ? in_sizes[0] : -1, out_size, ws_size, (size_t)WS_END); grid = -1; return; }
        int dev = 0, cus = 0, per_cu = 0;
        if (hipGetDevice(&dev) != hipSuccess || hipDeviceGetAttribute(&cus, hipDeviceAttributeMultiprocessorCount, dev) != hipSuccess) { grid = -1; return; }
        if (hipFuncSetAttribute((const void*)fwd, hipFuncAttributeMaxDynamicSharedMemorySize, LDS_BYTES) != hipSuccess) { fprintf(stderr, "kernel_launch: hipFuncSetAttribute failed\n"); grid = -1; return; }
        if (hipOccupancyMaxActiveBlocksPerMultiprocessor(&per_cu, (const void*)fwd, NWAVES * 64, LDS_BYTES) != hipSuccess || per_cu < 1)
            fprintf(stderr, "kernel_launch: note: occupancy query reports %d workgroups per CU\n", per_cu);
        (void)hipGetLastError();
        grid = cus;
    }
    if (grid < 0) return;
    if (hipMemsetAsync((char*)d_ws + WS_CTL, 0, CTL_ZERO_BYTES, stream) != hipSuccess) { fprintf(stderr, "kernel_launch: memset failed\n"); return; }
    Args a{};
    for (int i = 0; i < 22; ++i) a.in[i] = (const float*)d_in[i];
    a.out = (float*)d_out; a.ws = (unsigned char*)d_ws;
    hipLaunchKernelGGL(fwd, dim3(grid), dim3(NWAVES * 64), LDS_BYTES, stream, a);
    const hipError_t le = hipPeekAtLastError();
    if (le != hipSuccess) fprintf(stderr, "kernel_launch: launch failed: %s\n", hipGetErrorName(le));
}
```
